# Optimizing an MI355X kernel written in HIP

```python
import numpy as np
import jax, jax.numpy as jnp
from jax import lax

D_MODEL = 1024
BATCH = 4
SEQ = 8192
DEPTH = 2

SSD_HEADS = 8
SSD_HEAD_DIM = 64
SSD_INNER = SSD_HEADS * SSD_HEAD_DIM
SSD_GROUPS = 2
SSD_STATE = 128
SSD_CONV = 4
SSD_CHUNK = 128
SSD_XBC = SSD_INNER + 2 * SSD_GROUPS * SSD_STATE
RET_HEADS = 4
RET_QK_DIM = 64
RET_V_DIM = 128
RET_CHUNK = 128
MLA_HEADS = 8
MLA_Q_LORA = 256
MLA_KV_LORA = 128
MLA_NOPE = 64
MLA_ROPE = 32
MLA_V = 64
ATTN_BLOCK = 128
GLA_HEADS = 4
GLA_K_DIM = 64
GLA_V_DIM = 128
GLA_GATE_RANK = 16
GLA_GATE_NORM = 16.0
GLA_CHUNK = 64
N_BRANCHES = 4
BRANCH_WIDTH = 512
D_FF = 4 * D_MODEL
ROPE_THETA = 10000.0
RMS_EPS = 1e-6
MAX_POS_OFFSET = 4096
IN_WIDTH = (SSD_INNER + SSD_XBC + SSD_HEADS
            + RET_HEADS * (2 * RET_QK_DIM + 2 * RET_V_DIM)
            + MLA_Q_LORA + MLA_KV_LORA + MLA_ROPE
            + GLA_HEADS * (2 * GLA_K_DIM + 2 * GLA_V_DIM) + GLA_GATE_RANK
            + N_BRANCHES * D_MODEL)

kernel_name = "hybrid_ssd_ret_mla_gla_block"


def rms_norm(x, g, eps=RMS_EPS):
    xf = x.astype(jnp.float32)
    y = xf * lax.rsqrt(jnp.mean(xf * xf, axis=-1, keepdims=True) + eps)
    return (y * g.astype(jnp.float32)).astype(x.dtype)


def rope(x, positions):
    half = x.shape[-1] // 2
    inv_freq = ROPE_THETA ** (-jnp.arange(half, dtype=jnp.float32) / half)
    ang = positions.astype(jnp.float32)[:, :, None, None] * inv_freq
    cos, sin = jnp.cos(ang), jnp.sin(ang)
    xf = x.astype(jnp.float32)
    x1, x2 = xf[..., :half], xf[..., half:]
    return jnp.concatenate([x1 * cos - x2 * sin, x2 * cos + x1 * sin], axis=-1).astype(x.dtype)


def causal_depthwise_conv(x, w, b):
    k = w.shape[0]
    y = lax.conv_general_dilated(x, w[:, None, :], window_strides=(1,), padding=[(k - 1, 0)],
                                 dimension_numbers=('NWC', 'WIO', 'NWC'),
                                 feature_group_count=x.shape[-1])
    return y + b


def scalar_decay_chunked(q, k, v, log_g, chunk):
    b, l, h, n = q.shape
    p = v.shape[-1]
    nc = l // chunk
    qc = q.reshape(b, nc, chunk, h, n)
    kc = k.reshape(b, nc, chunk, h, n)
    vc = v.reshape(b, nc, chunk, h, p)
    a = log_g.astype(jnp.float32).reshape(b, nc, chunk, h).transpose(0, 3, 1, 2)
    cum = jnp.cumsum(a, axis=-1)
    seg = cum[..., :, None] - cum[..., None, :]
    mask = jnp.tril(jnp.ones((chunk, chunk), dtype=bool))
    decay = jnp.exp(jnp.where(mask, seg, -jnp.inf))
    scores = jnp.einsum('bcihn,bcjhn->bhcij', qc, kc) * decay
    y_diag = jnp.einsum('bhcij,bcjhp->bcihp', scores, vc)
    decay_to_end = jnp.exp(cum[..., -1:] - cum)
    states = jnp.einsum('bcjhn,bhcj,bcjhp->bchpn', kc, decay_to_end, vc)
    chunk_decay = jnp.exp(cum[..., -1])

    def step(carry, inp):
        dec, st = inp
        return dec[:, :, None, None] * carry + st, carry

    init = jnp.zeros((b, h, p, n), states.dtype)
    _, prev = lax.scan(step, init, (jnp.moveaxis(chunk_decay, 2, 0), jnp.moveaxis(states, 1, 0)))
    prev = jnp.moveaxis(prev, 0, 1)
    y_off = jnp.einsum('bcihn,bchpn,bhci->bcihp', qc, prev, jnp.exp(cum))
    return (y_diag + y_off).reshape(b, l, h, p).astype(v.dtype)


def gla_chunked(q, k, v, log_g, chunk):
    b, l, h, dk = q.shape
    dv = v.shape[-1]
    nc = l // chunk
    qc = q.reshape(b, nc, chunk, h, dk)
    kc = k.reshape(b, nc, chunk, h, dk)
    vc = v.reshape(b, nc, chunk, h, dv)
    cum = jnp.cumsum(log_g.astype(jnp.float32).reshape(b, nc, chunk, h, dk), axis=2)
    total = cum[:, :, -1:]
    q_in = qc * jnp.exp(cum)
    k_in = kc * jnp.exp(-cum)
    mask = jnp.tril(jnp.ones((chunk, chunk), dtype=bool))
    scores = jnp.where(mask, jnp.einsum('bcihd,bcjhd->bchij', q_in, k_in), 0.0)
    o_intra = jnp.einsum('bchij,bcjhv->bcihv', scores, vc)
    k_st = kc * jnp.exp(total - cum)
    states = jnp.einsum('bcjhd,bcjhv->bchdv', k_st, vc)
    chunk_decay = jnp.exp(total[:, :, 0])

    def step(carry, inp):
        dec, st = inp
        return dec[..., None] * carry + st, carry

    init = jnp.zeros((b, h, dk, dv), states.dtype)
    _, prev = lax.scan(step, init, (jnp.moveaxis(chunk_decay, 1, 0), jnp.moveaxis(states, 1, 0)))
    prev = jnp.moveaxis(prev, 0, 1)
    o_inter = jnp.einsum('bcihd,bchdv->bcihv', q_in, prev)
    return (o_intra + o_inter).reshape(b, l, h, dv).astype(v.dtype)


def causal_attention_blocked(q, k, v, scale):
    b, l, h, d = q.shape
    dv = v.shape[-1]
    nb = l // ATTN_BLOCK
    qb = q.reshape(b, nb, ATTN_BLOCK, h, d).transpose(1, 0, 2, 3, 4)
    starts = jnp.arange(nb, dtype=jnp.int32) * ATTN_BLOCK
    kpos = jnp.arange(l, dtype=jnp.int32)

    def one_block(args):
        qi, s0 = args
        s = jnp.einsum('bqhd,bkhd->bhqk', qi, k, preferred_element_type=jnp.float32) * scale
        qpos = s0 + jnp.arange(ATTN_BLOCK, dtype=jnp.int32)
        s = jnp.where(kpos[None, :] <= qpos[:, None], s, -jnp.inf)
        pr = jax.nn.softmax(s, axis=-1).astype(v.dtype)
        return jnp.einsum('bhqk,bkhd->bqhd', pr, v)

    o = lax.map(one_block, (qb, starts))
    return o.transpose(1, 0, 2, 3, 4).reshape(b, l, h, dv)


def ssd_mixer(z, xbc, dt_raw, conv_w, conv_b, dt_bias, a_log, d_skip, norm_g):
    b, l, _ = z.shape
    xbc = jax.nn.silu(causal_depthwise_conv(xbc, conv_w, conv_b))
    xs, bm, cm = jnp.split(xbc, [SSD_INNER, SSD_INNER + SSD_GROUPS * SSD_STATE], axis=-1)
    xs = xs.reshape(b, l, SSD_HEADS, SSD_HEAD_DIM)
    rep = SSD_HEADS // SSD_GROUPS
    bm = jnp.repeat(bm.reshape(b, l, SSD_GROUPS, SSD_STATE), rep, axis=2)
    cm = jnp.repeat(cm.reshape(b, l, SSD_GROUPS, SSD_STATE), rep, axis=2)
    dt = jax.nn.softplus(dt_raw.astype(jnp.float32) + dt_bias.astype(jnp.float32))
    a = -jnp.exp(a_log.astype(jnp.float32))
    y = scalar_decay_chunked(cm, bm, xs * dt[..., None].astype(xs.dtype), dt * a, SSD_CHUNK)
    y = y + d_skip[:, None] * xs
    y = y.reshape(b, l, SSD_INNER) * jax.nn.silu(z)
    y = rms_norm(y.reshape(b, l, SSD_GROUPS, SSD_INNER // SSD_GROUPS),
                 norm_g.reshape(SSD_GROUPS, SSD_INNER // SSD_GROUPS))
    return y.reshape(b, l, SSD_INNER)


def retention_mixer(q, k, v, g, positions, norm_g):
    b, l, _ = q.shape
    q = rope(q.reshape(b, l, RET_HEADS, RET_QK_DIM), positions)
    k = rope(k.reshape(b, l, RET_HEADS, RET_QK_DIM), positions) * (RET_QK_DIM ** -0.5)
    v = v.reshape(b, l, RET_HEADS, RET_V_DIM)
    log_gamma = jnp.log1p(-jnp.exp2(-5.0 - jnp.arange(RET_HEADS, dtype=jnp.float32)))
    log_g = jnp.broadcast_to(log_gamma, (b, l, RET_HEADS))
    y = scalar_decay_chunked(q, k, v, log_g, RET_CHUNK)
    y = rms_norm(y, norm_g.reshape(RET_HEADS, RET_V_DIM)).reshape(b, l, RET_HEADS * RET_V_DIM)
    return y * jax.nn.silu(g)


def mla_mixer(c_q, c_kv, k_rope, positions, q_norm, w_uq, kv_norm, w_ukv):
    b, l, _ = c_q.shape
    q = (rms_norm(c_q, q_norm) @ w_uq).reshape(b, l, MLA_HEADS, MLA_NOPE + MLA_ROPE)
    q_nope, q_pe = q[..., :MLA_NOPE], rope(q[..., MLA_NOPE:], positions)
    kv = (rms_norm(c_kv, kv_norm) @ w_ukv).reshape(b, l, MLA_HEADS, MLA_NOPE + MLA_V)
    k_nope, v = kv[..., :MLA_NOPE], kv[..., MLA_NOPE:]
    k_pe = rope(k_rope[:, :, None, :], positions)
    q = jnp.concatenate([q_nope, q_pe], axis=-1)
    k = jnp.concatenate([k_nope, jnp.broadcast_to(k_pe, (b, l, MLA_HEADS, MLA_ROPE))], axis=-1)
    o = causal_attention_blocked(q, k, v, (MLA_NOPE + MLA_ROPE) ** -0.5)
    return o.reshape(b, l, MLA_HEADS * MLA_V)


def gla_mixer(q, k, v, gk_low, g, w_gk2, b_gk, norm_g):
    b, l, _ = q.shape
    q = q.reshape(b, l, GLA_HEADS, GLA_K_DIM) * (GLA_K_DIM ** -0.5)
    k = k.reshape(b, l, GLA_HEADS, GLA_K_DIM)
    v = v.reshape(b, l, GLA_HEADS, GLA_V_DIM)
    log_g = jax.nn.log_sigmoid((gk_low @ w_gk2 + b_gk).astype(jnp.float32)) / GLA_GATE_NORM
    o = gla_chunked(q, k, v, log_g.reshape(b, l, GLA_HEADS, GLA_K_DIM), GLA_CHUNK)
    o = rms_norm(o, norm_g.reshape(GLA_HEADS, GLA_V_DIM)).reshape(b, l, GLA_HEADS * GLA_V_DIM)
    return o * jax.nn.silu(g)


def hybrid_layer(x, positions, w_in, b_gate, ssd_conv_w, ssd_conv_b, ssd_dt_bias, ssd_a_log, ssd_d,
                 ssd_norm, ret_norm, mla_q_norm, mla_w_uq, mla_kv_norm, mla_w_ukv, gla_w_gk2, gla_b_gk,
                 gla_norm, w_branch, w_out, norm_pre_mix, norm_post_mix, norm_pre_mlp, norm_post_mlp,
                 w_mlp_in, w_mlp_out):
    b, l, _ = x.shape
    h = rms_norm(x, norm_pre_mix)
    sizes = (SSD_INNER, SSD_XBC, SSD_HEADS,
             RET_HEADS * RET_QK_DIM, RET_HEADS * RET_QK_DIM, RET_HEADS * RET_V_DIM, RET_HEADS * RET_V_DIM,
             MLA_Q_LORA, MLA_KV_LORA, MLA_ROPE,
             GLA_HEADS * GLA_K_DIM, GLA_HEADS * GLA_K_DIM, GLA_HEADS * GLA_V_DIM, GLA_GATE_RANK,
             GLA_HEADS * GLA_V_DIM, N_BRANCHES * D_MODEL)
    idx = [int(s) for s in np.cumsum(sizes)[:-1]]
    (z, xbc, dt_raw, rq, rk, rv, rg, cq, ckv, kr,
     gq, gk, gv, ggk, gg, gate_logits) = jnp.split(h @ w_in, idx, axis=-1)

    y_ssd = ssd_mixer(z, xbc, dt_raw, ssd_conv_w, ssd_conv_b, ssd_dt_bias, ssd_a_log, ssd_d, ssd_norm)
    y_ret = retention_mixer(rq, rk, rv, rg, positions, ret_norm)
    y_mla = mla_mixer(cq, ckv, kr, positions, mla_q_norm, mla_w_uq, mla_kv_norm, mla_w_ukv)
    y_gla = gla_mixer(gq, gk, gv, ggk, gg, gla_w_gk2, gla_b_gk, gla_norm)

    ys = jnp.stack([y_ssd, y_ret, y_mla, y_gla], axis=2)
    branches = jnp.einsum('blnw,nwd->blnd', ys, w_branch)
    gates = jax.nn.sigmoid((gate_logits + b_gate).astype(jnp.float32)).astype(x.dtype)
    merged = jnp.sum(gates.reshape(b, l, N_BRANCHES, D_MODEL) * branches, axis=2)
    x = x + rms_norm(merged @ w_out, norm_post_mix)

    u = jnp.square(jax.nn.relu(rms_norm(x, norm_pre_mlp) @ w_mlp_in))
    return x + rms_norm(u @ w_mlp_out, norm_post_mlp)


def setup_inputs(seed: int = 0) -> dict:
    key = jax.random.key(seed)
    ks = jax.random.split(key, 32)
    f32 = jnp.float32
    L = DEPTH

    def nrm(k, shape, scale):
        return jax.random.normal(k, shape, f32) * scale

    def gain(k, shape):
        return 1.0 + 0.02 * jax.random.normal(k, shape, f32)

    x = nrm(ks[0], (BATCH, SEQ, D_MODEL), 1.0)
    offsets = jax.random.randint(ks[1], (BATCH, 1), 0, MAX_POS_OFFSET, dtype=jnp.int32)
    positions = offsets + jnp.arange(SEQ, dtype=jnp.int32)[None, :]
    dt = jnp.exp(jax.random.uniform(ks[2], (L, SSD_HEADS), f32) * (np.log(0.1) - np.log(0.001))
                 + np.log(0.001))
    ssd_dt_bias = dt + jnp.log(-jnp.expm1(-dt))
    ssd_a_log = jnp.log(jax.random.uniform(ks[3], (L, SSD_HEADS), f32, minval=1.0, maxval=16.0))
    return {
        "x": x,
        "positions": positions,
        "w_in": nrm(ks[4], (L, D_MODEL, IN_WIDTH), D_MODEL ** -0.5),
        "b_gate": nrm(ks[5], (L, N_BRANCHES * D_MODEL), 0.01),
        "ssd_conv_w": nrm(ks[6], (L, SSD_CONV, SSD_XBC), SSD_CONV ** -0.5),
        "ssd_conv_b": nrm(ks[7], (L, SSD_XBC), 0.01),
        "ssd_dt_bias": ssd_dt_bias,
        "ssd_a_log": ssd_a_log,
        "ssd_d": 1.0 + 0.1 * jax.random.normal(ks[8], (L, SSD_HEADS), f32),
        "ssd_norm": gain(ks[9], (L, SSD_INNER)),
        "ret_norm": gain(ks[10], (L, RET_HEADS * RET_V_DIM)),
        "mla_q_norm": gain(ks[11], (L, MLA_Q_LORA)),
        "mla_w_uq": nrm(ks[12], (L, MLA_Q_LORA, MLA_HEADS * (MLA_NOPE + MLA_ROPE)), MLA_Q_LORA ** -0.5),
        "mla_kv_norm": gain(ks[13], (L, MLA_KV_LORA)),
        "mla_w_ukv": nrm(ks[14], (L, MLA_KV_LORA, MLA_HEADS * (MLA_NOPE + MLA_V)), MLA_KV_LORA ** -0.5),
        "gla_w_gk2": nrm(ks[15], (L, GLA_GATE_RANK, GLA_HEADS * GLA_K_DIM), GLA_GATE_RANK ** -0.5),
        "gla_b_gk": nrm(ks[16], (L, GLA_HEADS * GLA_K_DIM), 0.01),
        "gla_norm": gain(ks[17], (L, GLA_HEADS * GLA_V_DIM)),
        "w_branch": nrm(ks[18], (L, N_BRANCHES, BRANCH_WIDTH, D_MODEL), BRANCH_WIDTH ** -0.5),
        "w_out": nrm(ks[19], (L, D_MODEL, D_MODEL), D_MODEL ** -0.5),
        "norm_pre_mix": gain(ks[20], (L, D_MODEL)),
        "norm_post_mix": gain(ks[21], (L, D_MODEL)),
        "norm_pre_mlp": gain(ks[22], (L, D_MODEL)),
        "norm_post_mlp": gain(ks[23], (L, D_MODEL)),
        "w_mlp_in": nrm(ks[24], (L, D_MODEL, D_FF), D_MODEL ** -0.5),
        "w_mlp_out": nrm(ks[25], (L, D_FF, D_MODEL), D_FF ** -0.5),
    }


def reference(x, positions, w_in, b_gate, ssd_conv_w, ssd_conv_b, ssd_dt_bias, ssd_a_log, ssd_d,
              ssd_norm, ret_norm, mla_q_norm, mla_w_uq, mla_kv_norm, mla_w_ukv, gla_w_gk2, gla_b_gk,
              gla_norm, w_branch, w_out, norm_pre_mix, norm_post_mix, norm_pre_mlp, norm_post_mlp,
              w_mlp_in, w_mlp_out):
    for i in range(DEPTH):
        x = hybrid_layer(x, positions, w_in[i], b_gate[i], ssd_conv_w[i], ssd_conv_b[i], ssd_dt_bias[i],
                         ssd_a_log[i], ssd_d[i], ssd_norm[i], ret_norm[i], mla_q_norm[i], mla_w_uq[i],
                         mla_kv_norm[i], mla_w_ukv[i], gla_w_gk2[i], gla_b_gk[i], gla_norm[i], w_branch[i],
                         w_out[i], norm_pre_mix[i], norm_post_mix[i], norm_pre_mlp[i], norm_post_mlp[i],
                         w_mlp_in[i], w_mlp_out[i])
    return x
```

```cpp
#include <hip/hip_runtime.h>
#include <hip/hip_cooperative_groups.h>
#include <cstdio>
#include <cstdint>
namespace cg = cooperative_groups;
#define DI __device__ __forceinline__
__device__ __forceinline__ int otid() { int t = (int)threadIdx.x; asm volatile("" : "+v"(t)); return t; }
__device__ __forceinline__ int obid() { int b = (int)blockIdx.x; asm volatile("" : "+s"(b)); return b; }
__device__ __forceinline__ unsigned char* ows(unsigned char* w) { asm volatile("" : "+s"(w)); return w; }
namespace pg8 {
#define PG8_LAS __attribute__((address_space(3)))
typedef unsigned short bf16_t;
typedef short bf16x8 __attribute__((ext_vector_type(8)));
typedef float f32x4 __attribute__((ext_vector_type(4)));
typedef unsigned u32x4 __attribute__((ext_vector_type(4)));
constexpr int BM = 256, BK = 64, HALF = 128, HTB = HALF * BK * 2  , STAGE_BYTES = 8 * HTB, NXCD = 8, WGM = 8;

__host__ __device__ __forceinline__ int lds_byte(int r, int c) { const int st = (r >> 4) * 2 + (c >> 5), rr = r & 15, cc = c & 31, ob = rr * 64 + cc * 2; return st * 1024 + (ob ^ (((ob >> 9) & 1) << 5)); }
__host__ __device__ __forceinline__ void stage_rc(int b, int& R, int& C) { const int st = b / 1024, sb = b % 1024, swz = sb ^ (((sb >> 9) & 1) << 5); R = (st >> 1) * 16 + swz / 64; C = (st & 1) * 32 + (swz % 64) / 2; }
__host__ __device__ __forceinline__ int perm32(int rho) { const int n = rho >> 4, i = rho & 15; return 8 * (i >> 2) + 4 * n + (i & 3); }

struct Unit { int pm, pn; };
struct Gemm { const bf16_t* A; const bf16_t* Bt; int M, N, K, lda, ldb; };

struct StaticOrder {
    int nM, nN, nwg, G, c;
    __host__ __device__ void init(int M, int N, int G_, int c_) { nM = M / BM; nN = N / BM; nwg = nM * nN; G = G_; c = c_; }
    __host__ __device__ bool next(int i, Unit& u) const {
        const long L = (long)i * G + c; if (L >= nwg) return false;
        int wgid = (int)L; { const int q = nwg / NXCD, r = nwg % NXCD, xcd = wgid % NXCD, off = wgid / NXCD; wgid = (xcd < r ? xcd * (q + 1) : r * (q + 1) + (xcd - r) * q) + off; }
        const int nig = WGM * nN, gid = wgid / nig, fm = gid * WGM, gsz = (nM - fm) < WGM ? (nM - fm) : WGM;
        u.pm = fm + ((wgid % nig) % gsz); u.pn = (wgid % nig) / gsz; return true;
    }
    __device__ __forceinline__ void a_ready(const Unit&) const {}
    __device__ __forceinline__ void done(const Unit&) const {}
};

typedef float f32x2 __attribute__((ext_vector_type(2)));
typedef unsigned u32x2 __attribute__((ext_vector_type(2)));
__device__ __forceinline__ unsigned pk2(float lo, float hi) { typedef __bf16 b2 __attribute__((ext_vector_type(2))); f32x2 v = {lo, hi}; b2 b = __builtin_convertvector(v, b2); return __builtin_bit_cast(unsigned, b); }
__device__ __forceinline__ float bflo(unsigned u) { return __uint_as_float(u << 16); }
__device__ __forceinline__ float bfhi(unsigned u) { return __uint_as_float(u & 0xffff0000u); }
__device__ __forceinline__ float sigm(float x) { return 1.0f / (1.0f + __expf(-x)); }

template <int ACT  > struct EpiStore {
    static constexpr bool PERM = true, AFTER_DRAIN = false;
    bf16_t* O; int ldc; const float* bias;
    __device__ __forceinline__ void operator()(const f32x4 (&acc)[2][2][4][2], const Unit& u, int wr, int wc, int fr, int fq) const {
        { const int ln_ = otid() & 63; fr = ln_ & 15; fq = ln_ >> 4; }
        const int row0 = u.pm * BM + wr * 64 + fr, col0 = u.pn * BM + wc * 32 + 8 * fq;
#pragma unroll
        for (int ai = 0; ai < 2; ++ai)
#pragma unroll
            for (int m = 0; m < 4; ++m) { bf16_t* rowp = O + (size_t)(row0 + ai * HALF + m * 16) * ldc + col0;
#pragma unroll
                for (int bj = 0; bj < 2; ++bj) { f32x4 v0 = acc[ai][bj][m][0], v1 = acc[ai][bj][m][1];
                    if (ACT == 1) {
#pragma unroll
                        for (int e = 0; e < 4; ++e) { float a = fmaxf(v0[e], 0.f), b = fmaxf(v1[e], 0.f); v0[e] = a * a; v1[e] = b * b; } }
                    if (ACT == 2) { const f32x4 b0 = *(const f32x4*)(bias + col0 + bj * HALF), b1 = *(const f32x4*)(bias + col0 + bj * HALF + 4);
#pragma unroll
                        for (int e = 0; e < 4; ++e) { v0[e] = sigm(v0[e] + b0[e]); v1[e] = sigm(v1[e] + b1[e]); } }
                    u32x4 w; w.x = pk2(v0[0], v0[1]); w.y = pk2(v0[2], v0[3]); w.z = pk2(v1[0], v1[1]); w.w = pk2(v1[2], v1[3]);
                    *(u32x4*)(rowp + bj * HALF) = w; } }
    }
};
struct EpiMerge {
    static constexpr bool PERM = true, AFTER_DRAIN = false;
    bf16_t* Mg; const bf16_t* G; int gcol0; const float* ssq; int sq0; int first;
    __device__ __forceinline__ void operator()(const f32x4 (&acc)[2][2][4][2], const Unit& u, int wr, int wc, int fr, int fq) const {
        { const int ln_ = otid() & 63; fr = ln_ & 15; fq = ln_ >> 4; }
        const int row0 = u.pm * BM + wr * 64 + fr, col0 = u.pn * BM + wc * 32 + 8 * fq;
#pragma unroll
        for (int ai = 0; ai < 2; ++ai)
#pragma unroll
            for (int m = 0; m < 4; ++m) { const int row = row0 + ai * HALF + m * 16;
                float rsc = 1.f;
                if (ssq) { const f32x4 s0 = *(const f32x4*)(ssq + (size_t)row * 16 + sq0), s1 = *(const f32x4*)(ssq + (size_t)row * 16 + sq0 + 4);
                    rsc = rsqrtf(((s0[0] + s0[1]) + (s0[2] + s0[3]) + (s1[0] + s1[1]) + (s1[2] + s1[3])) * (1.0f / 256.0f) + 1e-6f); }
#pragma unroll
                for (int bj = 0; bj < 2; ++bj) { const f32x4 v0 = acc[ai][bj][m][0], v1 = acc[ai][bj][m][1];
                    const u32x4 gw = *(const u32x4*)(G + (size_t)row * 4096 + gcol0 + col0 + bj * HALF);
                    float o[8];
                    o[0] = v0[0] * rsc * bflo(gw.x); o[1] = v0[1] * rsc * bfhi(gw.x); o[2] = v0[2] * rsc * bflo(gw.y); o[3] = v0[3] * rsc * bfhi(gw.y);
                    o[4] = v1[0] * rsc * bflo(gw.z); o[5] = v1[1] * rsc * bfhi(gw.z); o[6] = v1[2] * rsc * bflo(gw.w); o[7] = v1[3] * rsc * bfhi(gw.w);
                    bf16_t* mp = Mg + (size_t)row * 1024 + col0 + bj * HALF;
                    if (!first) { const u32x4 pw = *(const u32x4*)mp;
                        o[0] += bflo(pw.x); o[1] += bfhi(pw.x); o[2] += bflo(pw.y); o[3] += bfhi(pw.y); o[4] += bflo(pw.z); o[5] += bfhi(pw.z); o[6] += bflo(pw.w); o[7] += bfhi(pw.w); }
                    u32x4 w; w.x = pk2(o[0], o[1]); w.y = pk2(o[2], o[3]); w.z = pk2(o[4], o[5]); w.w = pk2(o[6], o[7]);
                    *(u32x4*)mp = w; asm volatile("" ::: "memory"); } }
    }
};
struct EpiQ {
    static constexpr bool PERM = false, AFTER_DRAIN = false;
    bf16_t* Q; const float* rs; const f32x2* rope; float qscale;
    __device__ __forceinline__ void operator()(const f32x4 (&acc)[2][2][4][2], const Unit& u, int wr, int wc, int fr, int fq) const {
        { const int ln_ = otid() & 63; fr = ln_ & 15; fq = ln_ >> 4; }
        const int row0 = u.pm * BM + wr * 64 + fr;
#pragma unroll
        for (int ai = 0; ai < 2; ++ai)
#pragma unroll
            for (int m = 0; m < 4; ++m) { const int row = row0 + ai * HALF + m * 16; const float sc = rs[row] * qscale;
#pragma unroll
                for (int bj = 0; bj < 2; ++bj) { const int cbase = u.pn * BM + bj * HALF + wc * 32; const bool ispe = ((cbase >> 5) % 3) == 2;
                    f32x4 v0 = acc[ai][bj][m][0] * sc, v1 = acc[ai][bj][m][1] * sc;
                    if (ispe) {
#pragma unroll
                        for (int e = 0; e < 4; ++e) { const f32x2 cs = rope[(size_t)row * 16 + 4 * fq + e]; const float a = v0[e], b = v1[e]; v0[e] = a * cs.x - b * cs.y; v1[e] = b * cs.x + a * cs.y; } }
                    bf16_t* qp = Q + (size_t)row * 768 + cbase + 4 * fq;
                    u32x2 w0, w1; w0.x = pk2(v0[0], v0[1]); w0.y = pk2(v0[2], v0[3]); w1.x = pk2(v1[0], v1[1]); w1.y = pk2(v1[2], v1[3]);
                    *(u32x2*)qp = w0; *(u32x2*)(qp + 16) = w1; asm volatile("" ::: "memory"); } }
    }
};
struct EpiKV {
    static constexpr bool PERM = false, AFTER_DRAIN = false;
    bf16_t* KN; bf16_t* VT; const float* rs; int ldv;
    __device__ __forceinline__ void operator()(const f32x4 (&acc)[2][2][4][2], const Unit& u, int wr, int wc, int fr, int fq) const {
        { const int ln_ = otid() & 63; fr = ln_ & 15; fq = ln_ >> 4; }
        const int row0 = u.pm * BM + wr * 64 + fr;
#pragma unroll
        for (int ai = 0; ai < 2; ++ai)
#pragma unroll
            for (int m = 0; m < 4; ++m) { const int row = row0 + ai * HALF + m * 16; const float sc = rs[row];
#pragma unroll
                for (int bj = 0; bj < 2; ++bj) { const int h = u.pn * 2 + bj;
#pragma unroll
                    for (int n = 0; n < 2; ++n) { const f32x4 v = acc[ai][bj][m][n] * sc;
                        if (wc < 2) { u32x2 w; w.x = pk2(v[0], v[1]); w.y = pk2(v[2], v[3]); *(u32x2*)(KN + (size_t)row * 512 + h * 64 + wc * 32 + 16 * n + 4 * fq) = w; }
                        else { const int d = (wc - 2) * 32 + 16 * n + 4 * fq; bf16_t* vp = VT + (size_t)(h * 64 + d) * ldv + row;
                            const unsigned a = pk2(v[0], v[1]), b = pk2(v[2], v[3]);
                            vp[0] = (bf16_t)(a & 0xffffu); vp[(size_t)ldv] = (bf16_t)(a >> 16); vp[2 * (size_t)ldv] = (bf16_t)(b & 0xffffu); vp[3 * (size_t)ldv] = (bf16_t)(b >> 16); } } asm volatile("" ::: "memory"); } }
    }
};

template <class Epi, class Sched, bool ALIGN_EPI = false, bool SP2 = false>
__device__ __forceinline__ void gemm_phase(PG8_LAS unsigned char* lds, const Gemm g, const Sched& S, const Epi& E) {
    const int tid = otid(), wid = __builtin_amdgcn_readfirstlane(tid >> 6), lane = tid & 63, wr = wid >> 2, wc = wid & 3, fr = lane & 15, fq = lane >> 4;
    const int K = g.K, nt = K / BK;
    unsigned voffA[2], voffB[2];
#pragma unroll
    for (int i = 0; i < 2; ++i) { int R, C; stage_rc(tid * 16 + i * 8192, R, C); const int Rb = Epi::PERM ? ((R & ~31) + perm32(R & 31)) : R;
        voffA[i] = (unsigned)(R * g.lda + C) * 2u; voffB[i] = (unsigned)(Rb * g.ldb + C) * 2u; }
    const size_t kstep = (size_t)(BK * 2);
    const size_t hstepA = (size_t)HALF * g.lda * 2, hstepB = (size_t)HALF * g.ldb * 2;
    const size_t tstepA = 2 * hstepA, tstepB = 2 * hstepB;
    const unsigned ldsw = (unsigned)wid * 1024u;
    const int aoff = lds_byte(wr * 64 + fr, fq * 8), boff = lds_byte(wc * 32 + fr, fq * 8);
#define PG8_SA(b, h) (((b) * 2 + (h)) * HTB)
#define PG8_SB(b, h) ((4 + (b) * 2 + (h)) * HTB)
#define PG8_STAGE(bufoff, gbase, voff) do { _Pragma("unroll") for (int _i = 0; _i < 2; ++_i) \
        __builtin_amdgcn_global_load_lds((const unsigned*)((const char*)(gbase) + (voff)[_i]), (PG8_LAS unsigned*)(lds + (bufoff) + ldsw + _i * 8192), 16, 0, 0); } while (0)
#define PG8_LDA(dst, b, h) do { _Pragma("unroll") for (int m = 0; m < 4; ++m) _Pragma("unroll") for (int k = 0; k < 2; ++k) dst[m][k] = *(const PG8_LAS bf16x8*)(lds + PG8_SA(b, h) + aoff + m * 2048 + k * 1024); } while (0)
#define PG8_LDB(dst, b, h) do { _Pragma("unroll") for (int n = 0; n < 2; ++n) _Pragma("unroll") for (int k = 0; k < 2; ++k) dst[n][k] = *(const PG8_LAS bf16x8*)(lds + PG8_SB(b, h) + boff + n * 2048 + k * 1024); } while (0)
#define PG8_MMA(ai, bj, At, Bt) do { __builtin_amdgcn_s_setprio(1); _Pragma("unroll") for (int m = 0; m < 4; ++m) _Pragma("unroll") for (int n = 0; n < 2; ++n) _Pragma("unroll") for (int k = 0; k < 2; ++k) \
        acc[ai][bj][m][n] = __builtin_amdgcn_mfma_f32_16x16x32_bf16(Bt[n][k], At[m][k], acc[ai][bj][m][n], 0, 0, 0); __builtin_amdgcn_s_setprio(0); } while (0)
#define PG8_WAIT_V(n) asm volatile("s_waitcnt vmcnt(" #n ")" ::: "memory")
#define PG8_WAIT_L(n) asm volatile("s_waitcnt lgkmcnt(" #n ")" ::: "memory")
#define PG8_BAR __builtin_amdgcn_s_barrier()
#define PG8_SCHED __builtin_amdgcn_sched_barrier(0)
    Unit cur, nxt; int ui = 0;
    if (!S.next(0, cur)) return;
    f32x4 acc[2][2][4][2];
#pragma unroll
    for (int a = 0; a < 2; ++a)
#pragma unroll
        for (int b = 0; b < 2; ++b)
#pragma unroll
            for (int m = 0; m < 4; ++m)
#pragma unroll
                for (int n = 0; n < 2; ++n) acc[a][b][m][n] = (f32x4){0.f, 0.f, 0.f, 0.f};
    bf16x8 At[4][2], B0[2][2], B1[2][2];
    const char* cA = (const char*)g.A + (size_t)cur.pm * tstepA; const char* cB = (const char*)g.Bt + (size_t)cur.pn * tstepB;
    S.a_ready(cur);
    if constexpr (SP2) {
        PG8_STAGE(PG8_SB(0, 0), cB, voffB); PG8_STAGE(PG8_SB(0, 1), cB + hstepB, voffB); PG8_STAGE(PG8_SA(0, 0), cA, voffA); PG8_STAGE(PG8_SA(0, 1), cA + hstepA, voffA);
        if (wr == 1) PG8_BAR;
        PG8_WAIT_V(2); PG8_BAR;
        PG8_STAGE(PG8_SB(1, 0), cB + kstep, voffB); PG8_STAGE(PG8_SA(1, 0), cA + kstep, voffA); PG8_STAGE(PG8_SB(1, 1), cB + hstepB + kstep, voffB);
        PG8_WAIT_V(6); PG8_BAR;
    } else {
        PG8_STAGE(PG8_SB(0, 0), cB, voffB); PG8_STAGE(PG8_SA(0, 0), cA, voffA); PG8_STAGE(PG8_SB(0, 1), cB + hstepB, voffB); PG8_STAGE(PG8_SA(0, 1), cA + hstepA, voffA);
        if (wr == 1) PG8_BAR;
        PG8_WAIT_V(4); PG8_BAR;
        PG8_STAGE(PG8_SB(1, 0), cB + kstep, voffB); PG8_STAGE(PG8_SA(1, 0), cA + kstep, voffA); PG8_STAGE(PG8_SB(1, 1), cB + hstepB + kstep, voffB);
        PG8_WAIT_V(6); PG8_BAR;
    }
    for (;;) {
        const bool has_next = S.next(ui + 1, nxt);
        const char* nA = has_next ? (const char*)g.A + (size_t)nxt.pm * tstepA : cA; const char* nB = has_next ? (const char*)g.Bt + (size_t)nxt.pn * tstepB : cB;
#pragma unroll 1
        for (int t = 0; t < nt; t += 2) {
            const bool last = (t == nt - 2);
            const char* a1 = cA + (size_t)(t + 1) * kstep;
            const char* a2 = last ? nA : cA + (size_t)(t + 2) * kstep; const char* b2 = last ? nB : cB + (size_t)(t + 2) * kstep;
            const char* a3 = a2 + kstep; const char* b3 = b2 + kstep;
            if (last && has_next) S.a_ready(nxt);
            if constexpr (SP2) {
            PG8_LDB(B0, 0, 0); PG8_LDB(B1, 0, 1); PG8_SCHED; PG8_LDA(At, 0, 0); PG8_STAGE(PG8_SA(1, 1), a1 + hstepA, voffA);
            PG8_WAIT_V(8); PG8_WAIT_L(0); PG8_BAR; PG8_MMA(0, 0, At, B0); PG8_MMA(0, 1, At, B1); PG8_BAR; PG8_SCHED;
            PG8_LDA(At, 0, 1); PG8_STAGE(PG8_SB(0, 0), b2, voffB); PG8_STAGE(PG8_SB(0, 1), b2 + hstepB, voffB); PG8_STAGE(PG8_SA(0, 0), a2, voffA);
            PG8_WAIT_V(8); PG8_WAIT_L(0); PG8_BAR; PG8_MMA(1, 0, At, B0); PG8_MMA(1, 1, At, B1); PG8_BAR; PG8_SCHED;
            PG8_LDB(B0, 1, 0); PG8_LDB(B1, 1, 1); PG8_SCHED; PG8_LDA(At, 1, 0); PG8_STAGE(PG8_SA(0, 1), a2 + hstepA, voffA);
            PG8_WAIT_V(8); PG8_WAIT_L(0); PG8_BAR; PG8_MMA(0, 0, At, B0); PG8_MMA(0, 1, At, B1); PG8_BAR; PG8_SCHED;
            PG8_LDA(At, 1, 1); PG8_STAGE(PG8_SB(1, 0), b3, voffB); PG8_STAGE(PG8_SB(1, 1), b3 + hstepB, voffB); PG8_STAGE(PG8_SA(1, 0), a3, voffA);
            PG8_WAIT_V(8); PG8_WAIT_L(0); PG8_BAR; PG8_MMA(1, 0, At, B0); PG8_MMA(1, 1, At, B1); PG8_BAR; PG8_SCHED;
            } else {
            PG8_LDB(B0, 0, 0); PG8_SCHED; PG8_LDA(At, 0, 0); PG8_STAGE(PG8_SA(1, 1), a1 + hstepA, voffA);
            PG8_WAIT_L(8); PG8_BAR; PG8_WAIT_L(0); PG8_MMA(0, 0, At, B0); PG8_BAR; PG8_SCHED;
            PG8_LDB(B1, 0, 1); PG8_STAGE(PG8_SB(0, 0), b2, voffB);
            PG8_BAR; PG8_WAIT_L(0); PG8_MMA(0, 1, At, B1); PG8_BAR;
            PG8_LDA(At, 0, 1); PG8_STAGE(PG8_SA(0, 0), a2, voffA);
            PG8_BAR; PG8_WAIT_L(0); PG8_MMA(1, 0, At, B0); PG8_BAR; PG8_SCHED;
            PG8_STAGE(PG8_SB(0, 1), b2 + hstepB, voffB);
            PG8_WAIT_V(6); PG8_BAR; PG8_MMA(1, 1, At, B1); PG8_BAR;
            PG8_LDB(B0, 1, 0); PG8_SCHED; PG8_LDA(At, 1, 0); PG8_STAGE(PG8_SA(0, 1), a2 + hstepA, voffA);
            PG8_WAIT_L(8); PG8_BAR; PG8_WAIT_L(0); PG8_MMA(0, 0, At, B0); PG8_BAR; PG8_SCHED;
            PG8_LDB(B1, 1, 1); PG8_STAGE(PG8_SB(1, 0), b3, voffB);
            PG8_BAR; PG8_WAIT_L(0); PG8_MMA(0, 1, At, B1); PG8_BAR;
            PG8_LDA(At, 1, 1); PG8_STAGE(PG8_SA(1, 0), a3, voffA);
            PG8_BAR; PG8_WAIT_L(0); PG8_MMA(1, 0, At, B0); PG8_BAR; PG8_SCHED;
            PG8_STAGE(PG8_SB(1, 1), b3 + hstepB, voffB);
            PG8_WAIT_V(6); PG8_BAR; PG8_MMA(1, 1, At, B1); PG8_BAR;
            }
        }
        if constexpr (ALIGN_EPI) { if (wr == 0) PG8_BAR; }
        if constexpr (!Epi::AFTER_DRAIN) { E(acc, cur, wr, wc, fr, fq); S.done(cur); }
        if (!has_next) break;
#pragma unroll
        for (int a = 0; a < 2; ++a)
#pragma unroll
            for (int b = 0; b < 2; ++b)
#pragma unroll
                for (int m = 0; m < 4; ++m)
#pragma unroll
                    for (int n = 0; n < 2; ++n) acc[a][b][m][n] = (f32x4){0.f, 0.f, 0.f, 0.f};
        cur = nxt; cA = nA; cB = nB; ++ui;
        if constexpr (ALIGN_EPI) { if (wr == 1) PG8_BAR; }
    }
    PG8_WAIT_V(0);
    if constexpr (!ALIGN_EPI) { if (wr == 0) PG8_BAR; }
    PG8_BAR;
    if constexpr (Epi::AFTER_DRAIN) { E.fused(acc, cur, wr, wc, fr, fq, lds, wid, lane); S.done(cur); }
#undef PG8_SA
#undef PG8_SB
#undef PG8_STAGE
#undef PG8_LDA
#undef PG8_LDB
#undef PG8_MMA
#undef PG8_WAIT_V
#undef PG8_WAIT_L
#undef PG8_BAR
#undef PG8_SCHED
}
}

using pg8::bf16_t; using pg8::bf16x8; using pg8::f32x4; using pg8::u32x4; using pg8::f32x2; using pg8::u32x2; using pg8::pk2; using pg8::bflo; using pg8::bfhi;
typedef float f32x16 __attribute__((ext_vector_type(16)));
#define LAS __attribute__((address_space(3)))
constexpr int DM = 1024, SEQL = 8192, NTOK = 4 * SEQL, TH = NTOK / 2, NLAYER = 2, INW = 9144, NP = 5120, DFF = 4096;
constexpr int C_Z = 0, C_XBC = 512, C_DT = 1536, C_RQ = 1544, C_RK = 1800, C_RV = 2056, C_RG = 2568, C_CQ = 3080, C_CKV = 3336, C_KR = 3464,
              C_GQ = 3496, C_GK = 3752, C_GV = 4008, C_GGK = 4520, C_GG = 4536, C_GATE = 5048;
constexpr float EPS = 1e-6f;
constexpr int NCH = SEQL / 64;
constexpr size_t MiB = 1024 * 1024;
constexpr size_t WS_WIN = 0, WS_WG = WS_WIN + 10 * MiB, WS_W1 = WS_WG + 8 * MiB, WS_W2 = WS_W1 + 8 * MiB, WS_WB = WS_W2 + 8 * MiB, WS_WO = WS_WB + 4 * MiB,
                 WS_WUQ = WS_WO + 2 * MiB, WS_WUKV = WS_WUQ + 512 * 1024, WS_ROPER = WS_WUKV + 512 * 1024, WS_ROPEM = WS_ROPER + 8 * MiB, WS_HN = WS_ROPEM + 4 * MiB,
                 WS_PROJ = WS_HN + 32 * MiB, WS_XBCC = WS_PROJ + 160 * MiB, WS_QM = WS_XBCC + 32 * MiB, WS_KN = WS_QM + 24 * MiB, WS_VT = WS_KN + 16 * MiB,
                 WS_ST0 = WS_VT + 16 * MiB, WS_ST1 = WS_ST0 + 32 * MiB, WS_ST2 = WS_ST1 + 16 * MiB, WS_YS = WS_ST2 + 16 * MiB, WS_DTT = WS_YS + 64 * MiB,
                 WS_CUMT = WS_DTT + 512 * 1024, WS_GTOT = WS_CUMT + 512 * 1024, WS_RSQ = WS_GTOT + 256 * 1024, WS_RSKV = WS_RSQ + 64 * 1024, WS_SSQ = WS_RSKV + 64 * 1024,
                 WS_KVR = WS_SSQ + 1 * MiB, WS_END = WS_KVR + 32 * MiB;
constexpr size_t WS_GATES = WS_PROJ, WS_MERGED = WS_PROJ + 128 * MiB, WS_U = WS_PROJ, WS_T = WS_XBCC;

struct KP {
    const float* x; const int* pos; const float* w_in; const float* b_gate; const float* conv_w; const float* conv_b; const float* dt_bias; const float* a_log; const float* ssd_d;
    const float* ssd_norm; const float* ret_norm; const float* mla_q_norm; const float* w_uq; const float* mla_kv_norm; const float* w_ukv; const float* w_gk2; const float* b_gk;
    const float* gla_norm; const float* w_branch; const float* w_out; const float* n_pre_mix; const float* n_post_mix; const float* n_pre_mlp; const float* n_post_mlp;
    const float* w_mlp_in; const float* w_mlp_out; float* out; unsigned char* ws;
};

DI float silu_f(float x) { return x / (1.0f + __expf(-x)); }
DI float softplus_f(float x) { return x > 20.f ? x : log1pf(__expf(x)); }
DI float logsigmoid_f(float x) { return fminf(x, 0.f) - log1pf(__expf(-fabsf(x))); }
DI int crow(int r, int hi) { return (r & 3) + 8 * (r >> 2) + 4 * hi; }
DI void unpack8(const u32x4 v, float* f) { f[0] = bflo(v.x); f[1] = bfhi(v.x); f[2] = bflo(v.y); f[3] = bfhi(v.y); f[4] = bflo(v.z); f[5] = bfhi(v.z); f[6] = bflo(v.w); f[7] = bfhi(v.w); }
DI u32x4 pack8(const float* f) { u32x4 w; w.x = pk2(f[0], f[1]); w.y = pk2(f[2], f[3]); w.z = pk2(f[4], f[5]); w.w = pk2(f[6], f[7]); return w; }
DI bf16_t f2bf(float x) { return (bf16_t)(pk2(x, 0.f) & 0xffffu); }
DI float bf2f(bf16_t h) { return __uint_as_float((unsigned)h << 16); }
DI float wave_sum(float v) {
#pragma unroll
    for (int o = 1; o < 64; o <<= 1) v += __shfl_xor(v, o);
    return v;
}
DI float half_sum32(float v) {
#pragma unroll
    for (int o = 1; o < 32; o <<= 1) v += __shfl_xor(v, o);
    return v;
}
#define MFMA32(a, b, c) __builtin_amdgcn_mfma_f32_32x32x16_bf16((a), (b), (c), 0, 0, 0)
DI f32x16 zero16() { f32x16 z;
#pragma unroll
    for (int i = 0; i < 16; ++i) z[i] = 0.f;
    return z; }

DI void wt_item(const float* W, int ldw, int c0, int ncols, const float* gk, bf16_t* WT, int K, int npad, int item, LAS float* scr, int lane) {
    const int nblk = npad / 32, kb = item / nblk, nb = item % nblk, k0 = 64 * kb, n0 = 32 * nb;
#pragma unroll 8
    for (int i = 0; i < 32; ++i) { const int kk = 2 * i + (lane >> 5), n = n0 + (lane & 31);
        float v = (n < ncols) ? W[(size_t)(k0 + kk) * ldw + c0 + n] : 0.f;
        if (gk) v *= gk[k0 + kk];
        scr[kk * 33 + (lane & 31)] = v; }
    __builtin_amdgcn_s_waitcnt(0xc07f); asm volatile("" ::: "memory");
    const int c = lane & 7;
#pragma unroll
    for (int j = 0; j < 4; ++j) { const int n = (lane >> 3) + 8 * j; const LAS float* s = scr + (8 * c) * 33 + n;
        u32x4 o; o.x = pk2(s[0 * 33], s[1 * 33]); o.y = pk2(s[2 * 33], s[3 * 33]); o.z = pk2(s[4 * 33], s[5 * 33]); o.w = pk2(s[6 * 33], s[7 * 33]);
        *(u32x4*)(WT + (size_t)(n0 + n) * K + k0 + 8 * c) = o; }
    __builtin_amdgcn_s_waitcnt(0xc07f); asm volatile("" ::: "memory");
}
DI void phase_weights(const KP& p, int ly, LAS unsigned char* lds) {
    const int tid = otid(), lane = tid & 63, wv = tid >> 6;
    LAS float* scr = (LAS float*)(lds + wv * 8704);
    const int gw = obid() * 8 + wv, NGW = gridDim.x * 8;
    unsigned char* ws = ows(p.ws);
    constexpr int I_IN = 16 * 160, I_G = 16 * 128, I_1 = 16 * 128, I_2 = 64 * 32, I_B = 8 * 32, I_O = 16 * 32, I_UQ = 4 * 24, I_UKV = 2 * 32;
    constexpr int NIT = I_IN + I_G + I_1 + I_2 + 4 * I_B + I_O + I_UQ + I_UKV;
    for (int it = gw; it < NIT; it += NGW) {
        int r = it;
        if (r < I_IN) { wt_item(p.w_in + (size_t)ly * DM * INW, INW, 0, C_GATE, nullptr, (bf16_t*)(ws + WS_WIN), DM, NP, r, scr, lane); continue; } r -= I_IN;
        if (r < I_G) { wt_item(p.w_in + (size_t)ly * DM * INW, INW, C_GATE, 4096, nullptr, (bf16_t*)(ws + WS_WG), DM, 4096, r, scr, lane); continue; } r -= I_G;
        if (r < I_1) { wt_item(p.w_mlp_in + (size_t)ly * DM * DFF, DFF, 0, DFF, nullptr, (bf16_t*)(ws + WS_W1), DM, DFF, r, scr, lane); continue; } r -= I_1;
        if (r < I_2) { wt_item(p.w_mlp_out + (size_t)ly * DFF * DM, DM, 0, DM, nullptr, (bf16_t*)(ws + WS_W2), DFF, DM, r, scr, lane); continue; } r -= I_2;
        if (r < 4 * I_B) { const int br = r / I_B; wt_item(p.w_branch + ((size_t)ly * 4 + br) * 512 * DM, DM, 0, DM, br == 0 ? p.ssd_norm + ly * 512 : nullptr,
                                                          (bf16_t*)(ws + WS_WB) + (size_t)br * DM * 512, 512, DM, r % I_B, scr, lane); continue; } r -= 4 * I_B;
        if (r < I_O) { wt_item(p.w_out + (size_t)ly * DM * DM, DM, 0, DM, nullptr, (bf16_t*)(ws + WS_WO), DM, DM, r, scr, lane); continue; } r -= I_O;
        if (r < I_UQ) { wt_item(p.w_uq + (size_t)ly * 256 * 768, 768, 0, 768, p.mla_q_norm + ly * 256, (bf16_t*)(ws + WS_WUQ), 256, 768, r, scr, lane); continue; } r -= I_UQ;
        wt_item(p.w_ukv + (size_t)ly * 128 * 1024, 1024, 0, 1024, p.mla_kv_norm + ly * 128, (bf16_t*)(ws + WS_WUKV), 128, 1024, r, scr, lane);
    }
}
DI void phase_rope_tables(const KP& p) {
    const int gt = obid() * 512 + otid(), NT = gridDim.x * 512;
    f32x2* rr = (f32x2*)(ows(p.ws) + WS_ROPER); f32x2* rm = (f32x2*)(ows(p.ws) + WS_ROPEM);
    for (int i = gt; i < NTOK * 48; i += NT) {
        const int t = i / 48, f = i % 48;
        const int half = f < 32 ? 32 : 16, fi = f < 32 ? f : f - 32;
        const float inv = (float)exp2(-(double)fi / (double)half * 13.287712379549449);
        const float ang = (float)p.pos[t] * inv;
        double tr = (double)ang * 0.15915494309189535; tr -= rint(tr);
        const float trf = (float)tr;
        f32x2 cs; cs.x = __builtin_amdgcn_cosf(trf); cs.y = __builtin_amdgcn_sinf(trf);
        if (f < 32) rr[(size_t)t * 32 + fi] = cs; else rm[(size_t)t * 16 + fi] = cs;
    }
}
DI void phase_norm0(const KP& p, int ly, int hf) {
    const int lane = otid() & 63, gw = obid() * 8 + (otid() >> 6), NGW = gridDim.x * 8;
    const float* xin = (ly == 0 ? p.x : p.out) + (size_t)hf * TH * DM; const float* g = p.n_pre_mix + ly * DM;
    bf16_t* hn = (bf16_t*)(ows(p.ws) + WS_HN);
    for (int r = gw; r < TH; r += NGW) {
        const f32x4* xr = (const f32x4*)(xin + (size_t)r * DM) + lane; f32x4 v[4]; float s = 0.f;
#pragma unroll
        for (int j = 0; j < 4; ++j) { v[j] = xr[64 * j]; s += (v[j][0] * v[j][0] + v[j][1] * v[j][1]) + (v[j][2] * v[j][2] + v[j][3] * v[j][3]); }
        const float rs = rsqrtf(wave_sum(s) * (1.f / DM) + EPS);
        u32x2* o = (u32x2*)(hn + (size_t)r * DM) + lane;
#pragma unroll
        for (int j = 0; j < 4; ++j) { const f32x4 gg = ((const f32x4*)g)[lane + 64 * j]; u32x2 w; w.x = pk2(v[j][0] * rs * gg[0], v[j][1] * rs * gg[1]); w.y = pk2(v[j][2] * rs * gg[2], v[j][3] * rs * gg[3]); o[64 * j] = w; }
    }
}
DI void phase_norm_res(const KP& p, int hf, const float* xin_base, const float* g1, const float* g2) {
    const int lane = otid() & 63, gw = obid() * 8 + (otid() >> 6), NGW = gridDim.x * 8;
    const float* xin = xin_base + (size_t)hf * TH * DM; float* xo = p.out + (size_t)hf * TH * DM;
    const bf16_t* tb = (const bf16_t*)(ows(p.ws) + WS_T); bf16_t* hn = (bf16_t*)(ows(p.ws) + WS_HN);
    for (int r = gw; r < TH; r += NGW) {
        const u32x2* tr = (const u32x2*)(tb + (size_t)r * DM) + lane; f32x4 tv[4]; float s = 0.f;
#pragma unroll
        for (int j = 0; j < 4; ++j) { const u32x2 w = tr[64 * j]; tv[j][0] = bflo(w.x); tv[j][1] = bfhi(w.x); tv[j][2] = bflo(w.y); tv[j][3] = bfhi(w.y);
            s += (tv[j][0] * tv[j][0] + tv[j][1] * tv[j][1]) + (tv[j][2] * tv[j][2] + tv[j][3] * tv[j][3]); }
        const float rs = rsqrtf(wave_sum(s) * (1.f / DM) + EPS);
        const f32x4* xr = (const f32x4*)(xin + (size_t)r * DM) + lane; f32x4* orow = (f32x4*)(xo + (size_t)r * DM) + lane; float s2 = 0.f;
#pragma unroll
        for (int j = 0; j < 4; ++j) { const f32x4 gg = ((const f32x4*)g1)[lane + 64 * j]; const f32x4 xv = xr[64 * j];
            tv[j] = xv + tv[j] * rs * gg; orow[64 * j] = tv[j];
            s2 += (tv[j][0] * tv[j][0] + tv[j][1] * tv[j][1]) + (tv[j][2] * tv[j][2] + tv[j][3] * tv[j][3]); }
        if (g2) {
            const float rs2 = rsqrtf(wave_sum(s2) * (1.f / DM) + EPS);
            u32x2* o = (u32x2*)(hn + (size_t)r * DM) + lane;
#pragma unroll
            for (int j = 0; j < 4; ++j) { const f32x4 gg = ((const f32x4*)g2)[lane + 64 * j]; u32x2 w; w.x = pk2(tv[j][0] * rs2 * gg[0], tv[j][1] * rs2 * gg[1]); w.y = pk2(tv[j][2] * rs2 * gg[2], tv[j][3] * rs2 * gg[3]); o[64 * j] = w; }
        }
    }
}

DI float ret_loggamma(int h) { return log1pf(-exp2f(-5.0f - (float)h)); }
DI void phase_prep(const KP& p, int ly, int hf) {
    const int tid = otid(), lane = tid & 63, wv = tid >> 6;
    const int gt = obid() * 512 + tid, NT = gridDim.x * 512, gw = obid() * 8 + wv, NGW = gridDim.x * 8;
    bf16_t* proj = (bf16_t*)(ows(p.ws) + WS_PROJ); bf16_t* xbcc = (bf16_t*)(ows(p.ws) + WS_XBCC);
    { const float* cw = p.conv_w + (size_t)ly * 4 * 1024; const float* cb = p.conv_b + (size_t)ly * 1024;
      for (int i = gt; i < TH * 128; i += NT) { const int t = i >> 7, c8 = (i & 127) * 8, l = t & (SEQL - 1);
        float a[8];
#pragma unroll
        for (int e = 0; e < 8; ++e) a[e] = cb[c8 + e];
#pragma unroll
        for (int j = 0; j < 4; ++j) { if (l - 3 + j >= 0) { float xv[8]; unpack8(*(const u32x4*)(proj + (size_t)(t - 3 + j) * NP + C_XBC + c8), xv);
#pragma unroll
            for (int e = 0; e < 8; ++e) a[e] += cw[j * 1024 + c8 + e] * xv[e]; } }
#pragma unroll
        for (int e = 0; e < 8; ++e) a[e] = silu_f(a[e]);
        *(u32x4*)(xbcc + (size_t)t * 1024 + c8) = pack8(a); } }
    { float* dtT = (float*)(ows(p.ws) + WS_DTT); float* cumT = (float*)(ows(p.ws) + WS_CUMT);
      for (int it = gw; it < (TH / 64) * 8; it += NGW) { const int ch = it >> 3, h = it & 7, t = ch * 64 + lane;
        const float dt = softplus_f(bf2f(proj[(size_t)t * NP + C_DT + h]) + p.dt_bias[ly * 8 + h]);
        float a = -__expf(p.a_log[ly * 8 + h]) * dt;
#pragma unroll
        for (int o = 1; o < 64; o <<= 1) { const float y = __shfl_up(a, o); if (lane >= o) a += y; }
        dtT[(size_t)h * TH + t] = dt; cumT[(size_t)h * TH + t] = a; } }
    { const f32x2* rr = (const f32x2*)(ows(p.ws) + WS_ROPER) + (size_t)hf * TH * 32;
      for (int i = gt; i < TH * 32; i += NT) { const int t = i >> 5, r = i & 31, which = r >> 4, h = (r >> 2) & 3, g = r & 3;
        bf16_t* base = proj + (size_t)t * NP + (which ? C_RK : C_RQ) + h * 64 + 8 * g; const float sc = which ? 0.125f : 1.0f;
        float x1[8], x2[8], o1[8], o2[8]; unpack8(*(const u32x4*)base, x1); unpack8(*(const u32x4*)(base + 32), x2);
#pragma unroll
        for (int e = 0; e < 8; ++e) { const f32x2 cs = rr[(size_t)t * 32 + 8 * g + e]; o1[e] = (x1[e] * cs.x - x2[e] * cs.y) * sc; o2[e] = (x2[e] * cs.x + x1[e] * cs.y) * sc; }
        *(u32x4*)base = pack8(o1); *(u32x4*)(base + 32) = pack8(o2); } }
    { const f32x2* rm = (const f32x2*)(ows(p.ws) + WS_ROPEM) + (size_t)hf * TH * 16;
      for (int i = gt; i < TH * 2; i += NT) { const int t = i >> 1, g = i & 1; bf16_t* base = proj + (size_t)t * NP + C_KR + 8 * g;
        float x1[8], x2[8], o1[8], o2[8]; unpack8(*(const u32x4*)base, x1); unpack8(*(const u32x4*)(base + 16), x2);
#pragma unroll
        for (int e = 0; e < 8; ++e) { const f32x2 cs = rm[(size_t)t * 16 + 8 * g + e]; o1[e] = x1[e] * cs.x - x2[e] * cs.y; o2[e] = x2[e] * cs.x + x1[e] * cs.y; }
        *(u32x4*)base = pack8(o1); *(u32x4*)(base + 16) = pack8(o2); } }
    { float* rsq = (float*)(ows(p.ws) + WS_RSQ); float* rskv = (float*)(ows(p.ws) + WS_RSKV);
      for (int it = gw; it < TH / 2; it += NGW) { const int row = it * 2 + (lane >> 5); float xv[8]; unpack8(*(const u32x4*)(proj + (size_t)row * NP + C_CQ + 8 * (lane & 31)), xv);
        float s = 0.f;
#pragma unroll
        for (int e = 0; e < 8; ++e) s += xv[e] * xv[e];
        s = half_sum32(s); if ((lane & 31) == 0) rsq[row] = rsqrtf(s * (1.f / 256.f) + EPS); }
      for (int it = gw; it < TH / 4; it += NGW) { const int row = it * 4 + (lane >> 4); float xv[8]; unpack8(*(const u32x4*)(proj + (size_t)row * NP + C_CKV + 8 * (lane & 15)), xv);
        float s = 0.f;
#pragma unroll
        for (int e = 0; e < 8; ++e) s += xv[e] * xv[e];
#pragma unroll
        for (int o = 1; o < 16; o <<= 1) s += __shfl_xor(s, o);
        if ((lane & 15) == 0) rskv[row] = rsqrtf(s * (1.f / 128.f) + EPS); } }
    { float* gtot = (float*)(ows(p.ws) + WS_GTOT); const float* w2 = p.w_gk2 + (size_t)ly * 16 * 256; const float* bb = p.b_gk + ly * 256;
      for (int it = gw; it < (TH / 64) * 4; it += NGW) { const int ch = it >> 2, h = it & 3, c = h * 64 + lane;
        float w[16];
#pragma unroll
        for (int r = 0; r < 16; ++r) w[r] = w2[r * 256 + c];
        const float b0 = bb[c]; float run = 0.f;
        for (int j = 0; j < 64; ++j) { const size_t t = (size_t)ch * 64 + j; bf16_t* row = proj + t * NP;
            float gl[16]; unpack8(*(const u32x4*)(row + C_GGK), gl); unpack8(*(const u32x4*)(row + C_GGK + 8), gl + 8);
            float xg = b0;
#pragma unroll
            for (int r = 0; r < 16; ++r) xg += gl[r] * w[r];
            run += logsigmoid_f(xg) * (1.0f / 16.0f);
            const float e = __expf(run);
            row[C_GQ + c] = f2bf(bf2f(row[C_GQ + c]) * 0.125f * e);
            row[C_GK + c] = f2bf(bf2f(row[C_GK + c]) / e); }
        gtot[(size_t)ch * 256 + c] = run; } }
}

template <int MIX> struct MixC { static constexpr int H = MIX == 0 ? 8 : 4, DK = MIX == 0 ? 128 : 64, DV = MIX == 0 ? 64 : 128; };
constexpr int LS = 72;
template <int MIX> DI bf16_t* st_base(const KP& p) { return (bf16_t*)(ows(p.ws) + (MIX == 0 ? WS_ST0 : MIX == 1 ? WS_ST1 : WS_ST2)); }
template <int MIX> DI const bf16_t* v_src(const KP& p, int h, size_t t) {
    return MIX == 0 ? (const bf16_t*)(ows(p.ws) + WS_XBCC) + t * 1024 + h * 64 : (const bf16_t*)(ows(p.ws) + WS_PROJ) + t * NP + (MIX == 1 ? C_RV : C_GV) + h * 128; }
template <int MIX> DI const bf16_t* k_src(const KP& p, int h, size_t t) {
    return MIX == 0 ? (const bf16_t*)(ows(p.ws) + WS_XBCC) + t * 1024 + 512 + (h >> 2) * 128 : (const bf16_t*)(ows(p.ws) + WS_PROJ) + t * NP + (MIX == 1 ? C_RK : C_GK) + h * 64; }
template <int MIX> DI const bf16_t* q_src(const KP& p, int h, size_t t) {
    return MIX == 0 ? (const bf16_t*)(ows(p.ws) + WS_XBCC) + t * 1024 + 768 + (h >> 2) * 128 : (const bf16_t*)(ows(p.ws) + WS_PROJ) + t * NP + (MIX == 1 ? C_RQ : C_GQ) + h * 64; }
template <int W, class SRC, class SCL> DI void stage_T(LAS bf16_t* img, int tid, SRC src, SCL scl) {
#pragma unroll
    for (int i = 0; i < W / 64; ++i) { const int idx = tid + 512 * i, tok = idx / (W / 8), ch = 8 * (idx % (W / 8));
        float v[8]; unpack8(*(const u32x4*)(src(tok) + ch), v); const float s = scl(tok);
#pragma unroll
        for (int e = 0; e < 8; ++e) img[(ch + e) * LS + tok] = f2bf(v[e] * s); }
}
template <int MIX> DI void pass1_item(const KP& p, int item, LAS unsigned char* lds) {
    constexpr int H = MixC<MIX>::H, DK = MixC<MIX>::DK, DV = MixC<MIX>::DV;
    const int tid = otid(), lane = tid & 63, wv = tid >> 6, l32 = lane & 31, hi = lane >> 5;
    const int c = item & 127, h = (item >> 7) % H, b = item / (128 * H); const size_t t0 = (size_t)b * SEQL + c * 64;
    LAS bf16_t* VtL = (LAS bf16_t*)lds; LAS bf16_t* KtL = VtL + DV * LS;
    const float* dtT = (const float*)(ows(p.ws) + WS_DTT) + (size_t)h * TH; const float* cumT = (const float*)(ows(p.ws) + WS_CUMT) + (size_t)h * TH;
    const float clast = MIX == 0 ? cumT[t0 + 63] : 0.f, lgam = MIX == 1 ? ret_loggamma(h) : 0.f;
    stage_T<DV>(VtL, tid, [&](int tok) { return v_src<MIX>(p, h, t0 + tok); },
                [&](int tok) { return MIX == 0 ? dtT[t0 + tok] * __expf(clast - cumT[t0 + tok]) : MIX == 1 ? __expf((float)(63 - tok) * lgam) : 1.0f; });
    stage_T<DK>(KtL, tid, [&](int tok) { return k_src<MIX>(p, h, t0 + tok); }, [&](int) { return 1.0f; });
    __syncthreads();
    constexpr int NTN = DK / 32; const int mv = wv / NTN, nk = wv % NTN;
    f32x16 acc = zero16();
#pragma unroll
    for (int ks = 0; ks < 4; ++ks) { const bf16x8 a = *(const LAS bf16x8*)(VtL + (32 * mv + l32) * LS + 16 * ks + 8 * hi), bq = *(const LAS bf16x8*)(KtL + (32 * nk + l32) * LS + 16 * ks + 8 * hi);
        acc = MFMA32(a, bq, acc); }
    bf16_t* St = st_base<MIX>(p) + (size_t)item * (DV * DK);
#pragma unroll
    for (int r = 0; r < 16; ++r) St[(32 * mv + crow(r, hi)) * DK + 32 * nk + l32] = f2bf(acc[r]);
    __syncthreads();
}
DI void phase_scan(const KP& p) {
    const int NT = gridDim.x * 512;
    for (int i = obid() * 512 + otid(); i < 131072; i += NT) {
        int mix, r = i; if (r < 65536) mix = 0; else if (r < 98304) { mix = 1; r -= 65536; } else { mix = 2; r -= 98304; }
        const int bh = r >> 12, e = r & 4095; const int H = mix == 0 ? 8 : 4, DKh = mix == 0 ? 64 : 32;
        const int b = bh / H, h = bh % H, dkp = e % DKh;
        unsigned* S = (unsigned*)(ows(p.ws) + (mix == 0 ? WS_ST0 : mix == 1 ? WS_ST1 : WS_ST2)) + (size_t)bh * 128 * 4096 + e;
        const float* cumT = (const float*)(ows(p.ws) + WS_CUMT) + (size_t)h * TH + (size_t)b * SEQL;
        const f32x2* gt = (const f32x2*)((const float*)(ows(p.ws) + WS_GTOT) + (size_t)b * NCH * 256 + h * 64) + dkp;
        const float dret = __expf(64.f * ret_loggamma(h));
        float r0 = 0.f, r1 = 0.f;
        for (int c0 = 0; c0 < NCH; c0 += 8) {
            unsigned v[8]; float d0[8], d1[8];
#pragma unroll
            for (int k = 0; k < 8; ++k) { v[k] = S[(size_t)(c0 + k) * 4096];
                if (mix == 0) { d0[k] = __expf(cumT[(c0 + k) * 64 + 63]); d1[k] = d0[k]; }
                else if (mix == 1) { d0[k] = dret; d1[k] = dret; }
                else { const f32x2 g = gt[(size_t)(c0 + k) * 128]; d0[k] = __expf(g.x); d1[k] = __expf(g.y); } }
#pragma unroll
            for (int k = 0; k < 8; ++k) { S[(size_t)(c0 + k) * 4096] = pk2(r0, r1);
                if (mix == 2) { r0 = d0[k] * (r0 + bflo(v[k])); r1 = d1[k] * (r1 + bfhi(v[k])); } else { r0 = d0[k] * r0 + bflo(v[k]); r1 = d1[k] * r1 + bfhi(v[k]); } }
        }
    }
}
template <int MIX> DI void pass3_item(const KP& p, int ly, int item, LAS unsigned char* lds) {
    constexpr int H = MixC<MIX>::H, DK = MixC<MIX>::DK, DV = MixC<MIX>::DV; constexpr bool SEG = MIX != 2;
    const int tid = otid(), lane = tid & 63, wv = tid >> 6, l32 = lane & 31, hi = lane >> 5;
    const int c = item & 127, h = (item >> 7) % H, b = item / (128 * H); const size_t t0 = (size_t)b * SEQL + c * 64;
    LAS bf16_t* PL = (LAS bf16_t*)lds; LAS bf16_t* VtL = PL + 64 * LS; LAS float* cumL = (LAS float*)(VtL + 128 * LS); LAS float* ssqL = cumL + 64;
    const float* dtT = (const float*)(ows(p.ws) + WS_DTT) + (size_t)h * TH; const float* cumT = (const float*)(ows(p.ws) + WS_CUMT) + (size_t)h * TH;
    stage_T<DV>(VtL, tid, [&](int tok) { return v_src<MIX>(p, h, t0 + tok); }, [&](int tok) { return MIX == 0 ? dtT[t0 + tok] : 1.0f; });
    if (tid < 64) cumL[tid] = MIX == 0 ? cumT[t0 + tid] : MIX == 1 ? (float)(tid + 1) * ret_loggamma(h) : 0.f;
    __syncthreads();
    if (wv < 4) { const int ti = wv >> 1, tj = wv & 1;
        if (tj <= ti) { f32x16 acc = zero16(); const bf16_t* qp = q_src<MIX>(p, h, t0 + 32 * ti + l32) + 8 * hi; const bf16_t* kp = k_src<MIX>(p, h, t0 + 32 * tj + l32) + 8 * hi;
#pragma unroll
            for (int ks = 0; ks < DK / 16; ++ks) acc = MFMA32(*(const bf16x8*)(qp + 16 * ks), *(const bf16x8*)(kp + 16 * ks), acc);
            const int j = 32 * tj + l32; const float cj = cumL[j];
#pragma unroll
            for (int r = 0; r < 16; ++r) { const int i = 32 * ti + crow(r, hi); float v = acc[r]; if (SEG) v *= __expf(fminf(cumL[i] - cj, 0.f)); if (j > i) v = 0.f; PL[i * LS + j] = f2bf(v); } } }
    __syncthreads();
    constexpr int NTN = DV / 32; const int ti = wv / NTN, tn = wv % NTN; const bool act = wv < 2 * NTN;
    f32x16 acc = zero16();
    if (act) {
        const bf16_t* qp = q_src<MIX>(p, h, t0 + 32 * ti + l32) + 8 * hi; const bf16_t* sp = st_base<MIX>(p) + (size_t)item * (DV * DK) + (32 * tn + l32) * DK + 8 * hi;
#pragma unroll
        for (int ks = 0; ks < DK / 16; ++ks) acc = MFMA32(*(const bf16x8*)(qp + 16 * ks), *(const bf16x8*)(sp + 16 * ks), acc);
        if (SEG) {
#pragma unroll
            for (int r = 0; r < 16; ++r) acc[r] *= __expf(cumL[32 * ti + crow(r, hi)]); }
#pragma unroll
        for (int ks = 0; ks < 4; ++ks) { if (ks < 2 || ti == 1) { const bf16x8 a = *(const LAS bf16x8*)(PL + (32 * ti + l32) * LS + 16 * ks + 8 * hi), bq = *(const LAS bf16x8*)(VtL + (32 * tn + l32) * LS + 16 * ks + 8 * hi);
            acc = MFMA32(a, bq, acc); } }
    }
    bf16_t* ys = (bf16_t*)(ows(p.ws) + WS_YS); const bf16_t* proj = (const bf16_t*)(ows(p.ws) + WS_PROJ); const int dv = 32 * tn + l32;
    if (MIX == 0) {
        if (act) { const bf16_t* xbcc = (const bf16_t*)(ows(p.ws) + WS_XBCC); float* ssq = (float*)(ows(p.ws) + WS_SSQ); const float dsk = p.ssd_d[ly * 8 + h];
#pragma unroll
            for (int r = 0; r < 16; ++r) { const size_t t = t0 + 32 * ti + crow(r, hi);
                float y = acc[r] + dsk * bf2f(xbcc[t * 1024 + h * 64 + dv]); y *= silu_f(bf2f(proj[t * NP + C_Z + h * 64 + dv]));
                const float s = half_sum32(y * y); if (l32 == 0) ssq[t * 16 + h * 2 + tn] = s;
                ys[t * 2048 + h * 64 + dv] = f2bf(y); } }
    } else {
#pragma unroll
        for (int r = 0; r < 16; ++r) { const float s = half_sum32(acc[r] * acc[r]); if (l32 == 0) ssqL[tn * 64 + 32 * ti + crow(r, hi)] = s; }
        __syncthreads();
        const float ng = (MIX == 1 ? p.ret_norm : p.gla_norm)[ly * 512 + h * 128 + dv];
#pragma unroll
        for (int r = 0; r < 16; ++r) { const int i = 32 * ti + crow(r, hi); const size_t t = t0 + i;
            const float tot = (ssqL[i] + ssqL[64 + i]) + (ssqL[128 + i] + ssqL[192 + i]); const float rs = rsqrtf(tot * (1.f / 128.f) + EPS);
            const float g = bf2f(proj[t * NP + (MIX == 1 ? C_RG : C_GG) + h * 128 + dv]);
            ys[t * 2048 + (MIX == 1 ? 512 : 1536) + h * 128 + dv] = f2bf(acc[r] * rs * ng * silu_f(g)); }
    }
    __syncthreads();
}

constexpr int KLS = 104, VLS = 72, ATT_KB = 64 * KLS * 2  , ATT_VB = 64 * VLS * 2  , ATT_BUF = ATT_KB + ATT_VB;
DI void attn_unit(const KP& p, int b, int h, int qb, LAS unsigned char* lds) {
    const int tid = otid(), lane = tid & 63, wv = tid >> 6, l32 = lane & 31, hi = lane >> 5;
    const bf16_t* QM = (const bf16_t*)(ows(p.ws) + WS_QM); const bf16_t* KN = (const bf16_t*)(ows(p.ws) + WS_KN); const bf16_t* VT = (const bf16_t*)(ows(p.ws) + WS_VT);
    const bf16_t* proj = (const bf16_t*)(ows(p.ws) + WS_PROJ); bf16_t* ys = (bf16_t*)(ows(p.ws) + WS_YS);
    const size_t tb = (size_t)b * SEQL; const int qloc0 = 256 * qb + 32 * wv, qloc = qloc0 + l32; const size_t tq = tb + qloc;
    bf16x8 qf[6];
#pragma unroll
    for (int s = 0; s < 6; ++s) qf[s] = *(const bf16x8*)(QM + tq * 768 + h * 96 + 16 * s + 8 * hi);
    f32x16 o0 = zero16(), o1 = zero16(); float mrun = -INFINITY, lsum = 0.f;
    const int nkt = 4 * qb + 4;
    const int k0key = tid / 12, k0c = tid % 12, k1id = tid + 512, k1key = k1id / 12, k1c = k1id % 12; const bool k1v = k1id < 768; const int vd = tid >> 3, vc = tid & 7;
    u32x4 rk0, rk1, rv;
#define ATT_LOAD(kt) do { const size_t tk = tb + 64 * (kt); \
        rk0 = (k0c < 8) ? *(const u32x4*)(KN + (tk + k0key) * 512 + h * 64 + 8 * k0c) : *(const u32x4*)(proj + (tk + k0key) * NP + C_KR + 8 * (k0c - 8)); \
        if (k1v) rk1 = (k1c < 8) ? *(const u32x4*)(KN + (tk + k1key) * 512 + h * 64 + 8 * k1c) : *(const u32x4*)(proj + (tk + k1key) * NP + C_KR + 8 * (k1c - 8)); \
        rv = *(const u32x4*)(VT + (size_t)(h * 64 + vd) * TH + tk + 8 * vc); } while (0)
#define ATT_STORE(buf) do { LAS unsigned char* B_ = lds + (buf) * ATT_BUF; \
        *(LAS u32x4*)(B_ + (k0key * KLS + 8 * k0c) * 2) = rk0; if (k1v) *(LAS u32x4*)(B_ + (k1key * KLS + 8 * k1c) * 2) = rk1; \
        *(LAS u32x4*)(B_ + ATT_KB + (vd * VLS + 8 * vc) * 2) = rv; } while (0)
    ATT_LOAD(0); ATT_STORE(0); __syncthreads();
    for (int kt = 0; kt < nkt; ++kt) {
        if (kt + 1 < nkt) ATT_LOAD(kt + 1);
        if (64 * kt <= qloc0 + 31) {
            const LAS bf16_t* KL = (const LAS bf16_t*)(lds + (kt & 1) * ATT_BUF); const LAS bf16_t* VL = (const LAS bf16_t*)(lds + (kt & 1) * ATT_BUF + ATT_KB);
            f32x16 s0 = zero16(), s1 = zero16();
#pragma unroll
            for (int s = 0; s < 6; ++s) { const bf16x8 ka = *(const LAS bf16x8*)(KL + l32 * KLS + 16 * s + 8 * hi), kb = *(const LAS bf16x8*)(KL + (32 + l32) * KLS + 16 * s + 8 * hi);
                s0 = MFMA32(ka, qf[s], s0); s1 = MFMA32(kb, qf[s], s1); }
            if (64 * kt + 63 > qloc0) {
#pragma unroll
                for (int r = 0; r < 16; ++r) { const int key = 64 * kt + crow(r, hi); if (key > qloc) s0[r] = -INFINITY; if (key + 32 > qloc) s1[r] = -INFINITY; } }
            float mx = fmaxf(s0[0], s1[0]);
#pragma unroll
            for (int r = 1; r < 16; ++r) mx = fmaxf(mx, fmaxf(s0[r], s1[r]));
            mx = fmaxf(mx, __shfl_xor(mx, 32));
            const float mnew = fmaxf(mrun, mx), alpha = exp2f(mrun - mnew); mrun = mnew;
            float ps = 0.f;
#pragma unroll
            for (int r = 0; r < 16; ++r) { s0[r] = exp2f(s0[r] - mnew); s1[r] = exp2f(s1[r] - mnew); ps += s0[r] + s1[r]; }
            lsum = lsum * alpha + ps;
#pragma unroll
            for (int r = 0; r < 16; ++r) { o0[r] *= alpha; o1[r] *= alpha; }
#pragma unroll
            for (int st = 0; st < 2; ++st)
#pragma unroll
                for (int t2 = 0; t2 < 2; ++t2) { u32x4 pw;
                    if (st == 0) { pw.x = pk2(s0[8 * t2], s0[8 * t2 + 1]); pw.y = pk2(s0[8 * t2 + 2], s0[8 * t2 + 3]); pw.z = pk2(s0[8 * t2 + 4], s0[8 * t2 + 5]); pw.w = pk2(s0[8 * t2 + 6], s0[8 * t2 + 7]); }
                    else { pw.x = pk2(s1[8 * t2], s1[8 * t2 + 1]); pw.y = pk2(s1[8 * t2 + 2], s1[8 * t2 + 3]); pw.z = pk2(s1[8 * t2 + 4], s1[8 * t2 + 5]); pw.w = pk2(s1[8 * t2 + 6], s1[8 * t2 + 7]); }
                    const bf16x8 pb = __builtin_bit_cast(bf16x8, pw); const int kof = 32 * st + 16 * t2 + 4 * hi;
                    { const u32x2 a0 = *(const LAS u32x2*)(VL + l32 * VLS + kof), a1 = *(const LAS u32x2*)(VL + l32 * VLS + kof + 8); u32x4 aw; aw.x = a0.x; aw.y = a0.y; aw.z = a1.x; aw.w = a1.y;
                      o0 = MFMA32(__builtin_bit_cast(bf16x8, aw), pb, o0); }
                    { const u32x2 a0 = *(const LAS u32x2*)(VL + (32 + l32) * VLS + kof), a1 = *(const LAS u32x2*)(VL + (32 + l32) * VLS + kof + 8); u32x4 aw; aw.x = a0.x; aw.y = a0.y; aw.z = a1.x; aw.w = a1.y;
                      o1 = MFMA32(__builtin_bit_cast(bf16x8, aw), pb, o1); } }
        }
        if (kt + 1 < nkt) ATT_STORE((kt + 1) & 1);
        __syncthreads();
    }
#undef ATT_LOAD
#undef ATT_STORE
    const float inv = 1.0f / (lsum + __shfl_xor(lsum, 32));
    bf16_t* op = ys + tq * 2048 + 1024 + h * 64 + 4 * hi;
#pragma unroll
    for (int g = 0; g < 4; ++g) { u32x2 w; w.x = pk2(o0[4 * g] * inv, o0[4 * g + 1] * inv); w.y = pk2(o0[4 * g + 2] * inv, o0[4 * g + 3] * inv); *(u32x2*)(op + 8 * g) = w;
        u32x2 w1; w1.x = pk2(o1[4 * g] * inv, o1[4 * g + 1] * inv); w1.y = pk2(o1[4 * g + 2] * inv, o1[4 * g + 3] * inv); *(u32x2*)(op + 32 + 8 * g) = w1; }
}

DI void phase_mla_fix(const KP& p, int hf, LAS unsigned char* lds) {
    const int tid = otid(), gt = obid() * 512 + tid, NT = gridDim.x * 512;
    bf16_t* QM = (bf16_t*)(ows(p.ws) + WS_QM); const bf16_t* KVR = (const bf16_t*)(ows(p.ws) + WS_KVR); bf16_t* KN = (bf16_t*)(ows(p.ws) + WS_KN); bf16_t* VT = (bf16_t*)(ows(p.ws) + WS_VT);
    const float* rsq = (const float*)(ows(p.ws) + WS_RSQ); const float* rskv = (const float*)(ows(p.ws) + WS_RSKV);
    const f32x2* rm = (const f32x2*)(ows(p.ws) + WS_ROPEM) + (size_t)hf * TH * 16;
    const float QSC = 0.14724445f;
    for (int i = gt; i < TH * 80; i += NT) { const int t = i / 80, r = i % 80, h = r / 10, g = r % 10; bf16_t* base = QM + (size_t)t * 768 + h * 96; const float sc = rsq[t] * QSC;
        if (g < 8) { float x[8]; unpack8(*(const u32x4*)(base + 8 * g), x);
#pragma unroll
            for (int e = 0; e < 8; ++e) x[e] *= sc;
            *(u32x4*)(base + 8 * g) = pack8(x); }
        else { const int gg = g - 8; float x1[8], x2[8], o1[8], o2[8]; unpack8(*(const u32x4*)(base + 64 + 8 * gg), x1); unpack8(*(const u32x4*)(base + 80 + 8 * gg), x2);
#pragma unroll
            for (int e = 0; e < 8; ++e) { const f32x2 cs = rm[(size_t)t * 16 + 8 * gg + e]; o1[e] = (x1[e] * cs.x - x2[e] * cs.y) * sc; o2[e] = (x2[e] * cs.x + x1[e] * cs.y) * sc; }
            *(u32x4*)(base + 64 + 8 * gg) = pack8(o1); *(u32x4*)(base + 80 + 8 * gg) = pack8(o2); } }
    for (int i = gt; i < TH * 64; i += NT) { const int t = i >> 6, h = (i >> 3) & 7, g = i & 7; float x[8]; unpack8(*(const u32x4*)(KVR + (size_t)t * 1024 + h * 128 + 8 * g), x); const float sc = rskv[t];
#pragma unroll
        for (int e = 0; e < 8; ++e) x[e] *= sc;
        *(u32x4*)(KN + (size_t)t * 512 + h * 64 + 8 * g) = pack8(x); }
    LAS bf16_t* img = (LAS bf16_t*)lds;
    for (int it = obid(); it < (TH / 64) * 8; it += gridDim.x) { const int tile = it >> 3, h = it & 7; const size_t t0 = (size_t)tile * 64; const int tok = tid >> 3, ch = 8 * (tid & 7);
        float x[8]; unpack8(*(const u32x4*)(KVR + (t0 + tok) * 1024 + h * 128 + 64 + ch), x); const float sc = rskv[t0 + tok];
#pragma unroll
        for (int e = 0; e < 8; ++e) img[(ch + e) * LS + tok] = f2bf(x[e] * sc);
        __syncthreads();
        *(u32x4*)(VT + (size_t)(h * 64 + tok) * TH + t0 + ch) = *(const LAS u32x4*)(img + tok * LS + ch);
        __syncthreads(); }
}

constexpr int LDS_BYTES = pg8::STAGE_BYTES;
template <class Epi, bool SP2 = true> DI void run_gemm(LAS unsigned char* lds, const bf16_t* A, int lda, const bf16_t* Bt, int ldb, int M, int N, int K, const Epi& E) {
    asm volatile("" : "+s"(K));
    pg8::Gemm g{A, Bt, M, N, K, lda, ldb}; pg8::StaticOrder S; S.init(M, N, (int)gridDim.x, obid());
    pg8::gemm_phase<Epi, pg8::StaticOrder, true, SP2>(lds, g, S, E);
}
#define ws (ows(p.ws))
#define hn ((bf16_t*)(ws + WS_HN))
#define proj ((bf16_t*)(ws + WS_PROJ))
#define ys ((bf16_t*)(ws + WS_YS))
__global__ void __launch_bounds__(512, 2) mega_fwd(KP p) {
    extern __shared__ __attribute__((aligned(16))) unsigned char lds_raw[];
    LAS unsigned char* lds = (LAS unsigned char*)lds_raw;
    cg::grid_group grid = cg::this_grid();
    phase_rope_tables(p);
#pragma unroll 1
    for (int ly = 0; ly < NLAYER; ++ly) {
#pragma unroll 1
        for (int hf = 0; hf < 2; ++hf) {

#ifndef NO_WT
            if (hf == 0) { phase_weights(p, ly, lds); }
#endif

            phase_norm0(p, ly, hf);
            grid.sync();

#ifndef NO_G1
            { pg8::EpiStore<0> E{proj, NP, nullptr}; run_gemm(lds, hn, DM, (const bf16_t*)(ws + WS_WIN), DM, TH, NP, DM, E); }
#endif

            grid.sync();

#ifndef NO_PREP
            phase_prep(p, ly, hf);
#endif

            grid.sync();

#ifndef NO_GQ
            { pg8::EpiStore<0> E{(bf16_t*)(ws + WS_QM), 768, nullptr}; run_gemm(lds, proj + C_CQ, NP, (const bf16_t*)(ws + WS_WUQ), 256, TH, 768, 256, E); }
#endif


#ifndef NO_GKV
            { pg8::EpiStore<0> E{(bf16_t*)(ws + WS_KVR), 1024, nullptr}; run_gemm(lds, proj + C_CKV, NP, (const bf16_t*)(ws + WS_WUKV), 128, TH, 1024, 128, E); }
#endif

            __syncthreads();

#ifndef NO_PASS1
            for (int it = obid(); it < 4096; it += gridDim.x) { if (it < 2048) pass1_item<0>(p, it, lds); else if (it < 3072) pass1_item<1>(p, it - 2048, lds); else pass1_item<2>(p, it - 3072, lds); }
#endif

            grid.sync();

#ifndef NO_SCAN
            phase_scan(p);
            phase_mla_fix(p, hf, lds);
#endif

            grid.sync();

#ifndef NO_ATTN
            for (int it = obid(); it < 256; it += gridDim.x) { const int b = it >> 7, h = (it >> 4) & 7, qa = it & 15;
                attn_unit(p, b, h, 31 - qa, lds); attn_unit(p, b, h, qa, lds); }
#endif


#ifndef NO_PASS3
            for (int it = obid(); it < 4096; it += gridDim.x) { if (it < 2048) pass3_item<0>(p, ly, it, lds); else if (it < 3072) pass3_item<1>(p, ly, it - 2048, lds); else pass3_item<2>(p, ly, it - 3072, lds); }
#endif

            grid.sync();

#ifndef NO_GG
            { pg8::EpiStore<2> E{(bf16_t*)(ws + WS_GATES), 4096, p.b_gate + (size_t)ly * 4096}; run_gemm(lds, hn, DM, (const bf16_t*)(ws + WS_WG), DM, TH, 4096, DM, E); }
#endif

            grid.sync();

#ifndef NO_GM
            { bf16_t* mg = (bf16_t*)(ws + WS_MERGED); const bf16_t* G = (const bf16_t*)(ws + WS_GATES); const bf16_t* WB = (const bf16_t*)(ws + WS_WB); const float* ssq = (const float*)(ws + WS_SSQ);
              { pg8::EpiMerge E{mg, G, 0, ssq, 0, 1}; run_gemm(lds, ys, 2048, WB, 512, TH, DM, 256, E); }
              { pg8::EpiMerge E{mg, G, 0, ssq, 8, 0}; run_gemm(lds, ys + 256, 2048, WB + 256, 512, TH, DM, 256, E); }
#pragma unroll 1
              for (int br = 1; br < 4; ++br) { pg8::EpiMerge E{mg, G, br * 1024, nullptr, 0, 0}; run_gemm(lds, ys + br * 512, 2048, WB + (size_t)br * DM * 512, 512, TH, DM, 512, E); } }
#endif

            grid.sync();

#ifndef NO_GO
            { pg8::EpiStore<0> E{(bf16_t*)(ws + WS_T), DM, nullptr}; run_gemm(lds, (const bf16_t*)(ws + WS_MERGED), DM, (const bf16_t*)(ws + WS_WO), DM, TH, DM, DM, E); }
#endif

            grid.sync();
            phase_norm_res(p, hf, ly == 0 ? p.x : p.out, p.n_post_mix + ly * DM, p.n_pre_mlp + ly * DM);
            grid.sync();

#ifndef NO_G2
            { pg8::EpiStore<1> E{(bf16_t*)(ws + WS_U), DFF, nullptr}; run_gemm(lds, hn, DM, (const bf16_t*)(ws + WS_W1), DM, TH, DFF, DM, E); }
#endif

            grid.sync();

#ifndef NO_G3
            { pg8::EpiStore<0> E{(bf16_t*)(ws + WS_T), DM, nullptr}; run_gemm(lds, (const bf16_t*)(ws + WS_U), DFF, (const bf16_t*)(ws + WS_W2), DFF, TH, DM, DFF, E); }
#endif

            grid.sync();
            phase_norm_res(p, hf, p.out, p.n_post_mlp + ly * DM, nullptr);
            __syncthreads();
        }
    }
}

#undef ws
#undef hn
#undef proj
#undef ys
extern "C" void kernel_launch(void* const* d_in, const int* in_sizes, int n_in, void* d_out, int out_size, void* d_ws, size_t ws_size, hipStream_t stream) {
    static int grid_blocks = 0;
    if (grid_blocks == 0) {
        if (n_in != 26 || ws_size < WS_END) { fprintf(stderr, "kernel_launch: unexpected n_in %d or ws_size %zu (< %zu)\n", n_in, ws_size, (size_t)WS_END); grid_blocks = -1; return; }
        int dev = 0, cus = 0, per_cu = 0;
        hipGetDevice(&dev); hipDeviceGetAttribute(&cus, hipDeviceAttributeMultiprocessorCount, dev);
        if (hipFuncSetAttribute((const void*)mega_fwd, hipFuncAttributeMaxDynamicSharedMemorySize, LDS_BYTES) != hipSuccess) { fprintf(stderr, "kernel_launch: hipFuncSetAttribute failed\n"); grid_blocks = -1; return; }
        if (hipOccupancyMaxActiveBlocksPerMultiprocessor(&per_cu, (const void*)mega_fwd, 512, LDS_BYTES) != hipSuccess || per_cu < 1) { fprintf(stderr, "kernel_launch: occupancy query gave %d\n", per_cu); per_cu = 1; }
        (void)hipGetLastError();
        grid_blocks = cus * 1;
    }
    if (grid_blocks < 0) return;
    KP p{};
    const float** pf = (const float**)&p;
    p.x = (const float*)d_in[0]; p.pos = (const int*)d_in[1];
    p.w_in = (const float*)d_in[2]; p.b_gate = (const float*)d_in[3]; p.conv_w = (const float*)d_in[4]; p.conv_b = (const float*)d_in[5]; p.dt_bias = (const float*)d_in[6];
    p.a_log = (const float*)d_in[7]; p.ssd_d = (const float*)d_in[8]; p.ssd_norm = (const float*)d_in[9]; p.ret_norm = (const float*)d_in[10]; p.mla_q_norm = (const float*)d_in[11];
    p.w_uq = (const float*)d_in[12]; p.mla_kv_norm = (const float*)d_in[13]; p.w_ukv = (const float*)d_in[14]; p.w_gk2 = (const float*)d_in[15]; p.b_gk = (const float*)d_in[16];
    p.gla_norm = (const float*)d_in[17]; p.w_branch = (const float*)d_in[18]; p.w_out = (const float*)d_in[19]; p.n_pre_mix = (const float*)d_in[20]; p.n_post_mix = (const float*)d_in[21];
    p.n_pre_mlp = (const float*)d_in[22]; p.n_post_mlp = (const float*)d_in[23]; p.w_mlp_in = (const float*)d_in[24]; p.w_mlp_out = (const float*)d_in[25];
    p.out = (float*)d_out; p.ws = (unsigned char*)d_ws; (void)pf;
    void* args[] = {&p};
    hipError_t e = hipLaunchCooperativeKernel((const void*)mega_fwd, dim3(grid_blocks), dim3(512), args, LDS_BYTES, stream);
    if (e != hipSuccess) fprintf(stderr, "kernel_launch: cooperative launch failed: %s (grid %d)\n", hipGetErrorString(e), grid_blocks);
}
```

```cpp
#include <hip/hip_runtime.h>
#include <hip/hip_cooperative_groups.h>
#include <cstdio>
#include <cstdint>
namespace cg = cooperative_groups;
#define DI __device__ __forceinline__
__device__ __forceinline__ int otid() { int t = (int)threadIdx.x; asm volatile("" : "+v"(t)); return t; }
__device__ __forceinline__ int obid() { int b = (int)blockIdx.x; asm volatile("" : "+s"(b)); return b; }
__device__ __forceinline__ unsigned char* ows(unsigned char* w) { asm volatile("" : "+s"(w)); return w; }
namespace pg8 {
#define PG8_LAS __attribute__((address_space(3)))
typedef unsigned short bf16_t;
typedef short bf16x8 __attribute__((ext_vector_type(8)));
typedef float f32x4 __attribute__((ext_vector_type(4)));
typedef unsigned u32x4 __attribute__((ext_vector_type(4)));
constexpr int BM = 256, BK = 64, HALF = 128, HTB = HALF * BK * 2  , STAGE_BYTES = 8 * HTB, NXCD = 8, WGM = 8;

__host__ __device__ __forceinline__ int lds_byte(int r, int c) { const int st = (r >> 4) * 2 + (c >> 5), rr = r & 15, cc = c & 31, ob = rr * 64 + cc * 2; return st * 1024 + (ob ^ (((ob >> 9) & 1) << 5)); }
__host__ __device__ __forceinline__ void stage_rc(int b, int& R, int& C) { const int st = b / 1024, sb = b % 1024, swz = sb ^ (((sb >> 9) & 1) << 5); R = (st >> 1) * 16 + swz / 64; C = (st & 1) * 32 + (swz % 64) / 2; }
__host__ __device__ __forceinline__ int perm32(int rho) { const int n = rho >> 4, i = rho & 15; return 8 * (i >> 2) + 4 * n + (i & 3); }

struct Unit { int pm, pn; };
struct Gemm { const bf16_t* A; const bf16_t* Bt; int M, N, K, lda, ldb; };

struct StaticOrder {
    int nM, nN, nwg, G, c;
    __host__ __device__ void init(int M, int N, int G_, int c_) { nM = M / BM; nN = N / BM; nwg = nM * nN; G = G_; c = c_; }
    __host__ __device__ bool next(int i, Unit& u) const {
        const long L = (long)i * G + c; if (L >= nwg) return false;
        int wgid = (int)L; { const int q = nwg / NXCD, r = nwg % NXCD, xcd = wgid % NXCD, off = wgid / NXCD; wgid = (xcd < r ? xcd * (q + 1) : r * (q + 1) + (xcd - r) * q) + off; }
        const int nig = WGM * nN, gid = wgid / nig, fm = gid * WGM, gsz = (nM - fm) < WGM ? (nM - fm) : WGM;
        u.pm = fm + ((wgid % nig) % gsz); u.pn = (wgid % nig) / gsz; return true;
    }
    __device__ __forceinline__ void a_ready(const Unit&) const {}
    __device__ __forceinline__ void done(const Unit&) const {}
};

typedef float f32x2 __attribute__((ext_vector_type(2)));
typedef unsigned u32x2 __attribute__((ext_vector_type(2)));
__device__ __forceinline__ unsigned pk2(float lo, float hi) { typedef __bf16 b2 __attribute__((ext_vector_type(2))); f32x2 v = {lo, hi}; b2 b = __builtin_convertvector(v, b2); return __builtin_bit_cast(unsigned, b); }
__device__ __forceinline__ float bflo(unsigned u) { return __uint_as_float(u << 16); }
__device__ __forceinline__ float bfhi(unsigned u) { return __uint_as_float(u & 0xffff0000u); }
__device__ __forceinline__ float sigm(float x) { return 1.0f / (1.0f + __expf(-x)); }

template <int ACT  > struct EpiStore {
    static constexpr bool PERM = true, AFTER_DRAIN = false;
    bf16_t* O; int ldc; const float* bias;
    __device__ __forceinline__ void operator()(const f32x4 (&acc)[2][2][4][2], const Unit& u, int wr, int wc, int fr, int fq) const {
        { const int ln_ = otid() & 63; fr = ln_ & 15; fq = ln_ >> 4; }
        const int row0 = u.pm * BM + wr * 64 + fr, col0 = u.pn * BM + wc * 32 + 8 * fq;
#pragma unroll
        for (int ai = 0; ai < 2; ++ai)
#pragma unroll
            for (int m = 0; m < 4; ++m) { bf16_t* rowp = O + (size_t)(row0 + ai * HALF + m * 16) * ldc + col0;
#pragma unroll
                for (int bj = 0; bj < 2; ++bj) { f32x4 v0 = acc[ai][bj][m][0], v1 = acc[ai][bj][m][1];
                    if (ACT == 1) {
#pragma unroll
                        for (int e = 0; e < 4; ++e) { float a = fmaxf(v0[e], 0.f), b = fmaxf(v1[e], 0.f); v0[e] = a * a; v1[e] = b * b; } }
                    if (ACT == 2) { const f32x4 b0 = *(const f32x4*)(bias + col0 + bj * HALF), b1 = *(const f32x4*)(bias + col0 + bj * HALF + 4);
#pragma unroll
                        for (int e = 0; e < 4; ++e) { v0[e] = sigm(v0[e] + b0[e]); v1[e] = sigm(v1[e] + b1[e]); } }
                    u32x4 w; w.x = pk2(v0[0], v0[1]); w.y = pk2(v0[2], v0[3]); w.z = pk2(v1[0], v1[1]); w.w = pk2(v1[2], v1[3]);
                    *(u32x4*)(rowp + bj * HALF) = w; } }
    }
};
struct EpiMerge {
    static constexpr bool PERM = true, AFTER_DRAIN = false;
    bf16_t* Mg; const bf16_t* G; int gcol0; const float* ssq; int sq0; int first;
    __device__ __forceinline__ void operator()(const f32x4 (&acc)[2][2][4][2], const Unit& u, int wr, int wc, int fr, int fq) const {
        { const int ln_ = otid() & 63; fr = ln_ & 15; fq = ln_ >> 4; }
        const int row0 = u.pm * BM + wr * 64 + fr, col0 = u.pn * BM + wc * 32 + 8 * fq;
#pragma unroll
        for (int ai = 0; ai < 2; ++ai)
#pragma unroll
            for (int m = 0; m < 4; ++m) { const int row = row0 + ai * HALF + m * 16;
                float rsc = 1.f;
                if (ssq) { const f32x4 s0 = *(const f32x4*)(ssq + (size_t)row * 16 + sq0), s1 = *(const f32x4*)(ssq + (size_t)row * 16 + sq0 + 4);
                    rsc = rsqrtf(((s0[0] + s0[1]) + (s0[2] + s0[3]) + (s1[0] + s1[1]) + (s1[2] + s1[3])) * (1.0f / 256.0f) + 1e-6f); }
#pragma unroll
                for (int bj = 0; bj < 2; ++bj) { const f32x4 v0 = acc[ai][bj][m][0], v1 = acc[ai][bj][m][1];
                    const u32x4 gw = *(const u32x4*)(G + (size_t)row * 4096 + gcol0 + col0 + bj * HALF);
                    float o[8];
                    o[0] = v0[0] * rsc * bflo(gw.x); o[1] = v0[1] * rsc * bfhi(gw.x); o[2] = v0[2] * rsc * bflo(gw.y); o[3] = v0[3] * rsc * bfhi(gw.y);
                    o[4] = v1[0] * rsc * bflo(gw.z); o[5] = v1[1] * rsc * bfhi(gw.z); o[6] = v1[2] * rsc * bflo(gw.w); o[7] = v1[3] * rsc * bfhi(gw.w);
                    bf16_t* mp = Mg + (size_t)row * 1024 + col0 + bj * HALF;
                    if (!first) { const u32x4 pw = *(const u32x4*)mp;
                        o[0] += bflo(pw.x); o[1] += bfhi(pw.x); o[2] += bflo(pw.y); o[3] += bfhi(pw.y); o[4] += bflo(pw.z); o[5] += bfhi(pw.z); o[6] += bflo(pw.w); o[7] += bfhi(pw.w); }
                    u32x4 w; w.x = pk2(o[0], o[1]); w.y = pk2(o[2], o[3]); w.z = pk2(o[4], o[5]); w.w = pk2(o[6], o[7]);
                    *(u32x4*)mp = w; asm volatile("" ::: "memory"); } }
    }
};
struct EpiQ {
    static constexpr bool PERM = false, AFTER_DRAIN = false;
    bf16_t* Q; const float* rs; const f32x2* rope; float qscale;
    __device__ __forceinline__ void operator()(const f32x4 (&acc)[2][2][4][2], const Unit& u, int wr, int wc, int fr, int fq) const {
        { const int ln_ = otid() & 63; fr = ln_ & 15; fq = ln_ >> 4; }
        const int row0 = u.pm * BM + wr * 64 + fr;
#pragma unroll
        for (int ai = 0; ai < 2; ++ai)
#pragma unroll
            for (int m = 0; m < 4; ++m) { const int row = row0 + ai * HALF + m * 16; const float sc = rs[row] * qscale;
#pragma unroll
                for (int bj = 0; bj < 2; ++bj) { const int cbase = u.pn * BM + bj * HALF + wc * 32; const bool ispe = ((cbase >> 5) % 3) == 2;
                    f32x4 v0 = acc[ai][bj][m][0] * sc, v1 = acc[ai][bj][m][1] * sc;
                    if (ispe) {
#pragma unroll
                        for (int e = 0; e < 4; ++e) { const f32x2 cs = rope[(size_t)row * 16 + 4 * fq + e]; const float a = v0[e], b = v1[e]; v0[e] = a * cs.x - b * cs.y; v1[e] = b * cs.x + a * cs.y; } }
                    bf16_t* qp = Q + (size_t)row * 768 + cbase + 4 * fq;
                    u32x2 w0, w1; w0.x = pk2(v0[0], v0[1]); w0.y = pk2(v0[2], v0[3]); w1.x = pk2(v1[0], v1[1]); w1.y = pk2(v1[2], v1[3]);
                    *(u32x2*)qp = w0; *(u32x2*)(qp + 16) = w1; asm volatile("" ::: "memory"); } }
    }
};
struct EpiKV {
    static constexpr bool PERM = false, AFTER_DRAIN = false;
    bf16_t* KN; bf16_t* VT; const float* rs; int ldv;
    __device__ __forceinline__ void operator()(const f32x4 (&acc)[2][2][4][2], const Unit& u, int wr, int wc, int fr, int fq) const {
        { const int ln_ = otid() & 63; fr = ln_ & 15; fq = ln_ >> 4; }
        const int row0 = u.pm * BM + wr * 64 + fr;
#pragma unroll
        for (int ai = 0; ai < 2; ++ai)
#pragma unroll
            for (int m = 0; m < 4; ++m) { const int row = row0 + ai * HALF + m * 16; const float sc = rs[row];
#pragma unroll
                for (int bj = 0; bj < 2; ++bj) { const int h = u.pn * 2 + bj;
#pragma unroll
                    for (int n = 0; n < 2; ++n) { const f32x4 v = acc[ai][bj][m][n] * sc;
                        if (wc < 2) { u32x2 w; w.x = pk2(v[0], v[1]); w.y = pk2(v[2], v[3]); *(u32x2*)(KN + (size_t)row * 512 + h * 64 + wc * 32 + 16 * n + 4 * fq) = w; }
                        else { const int d = (wc - 2) * 32 + 16 * n + 4 * fq; bf16_t* vp = VT + (size_t)(h * 64 + d) * ldv + row;
                            const unsigned a = pk2(v[0], v[1]), b = pk2(v[2], v[3]);
                            vp[0] = (bf16_t)(a & 0xffffu); vp[(size_t)ldv] = (bf16_t)(a >> 16); vp[2 * (size_t)ldv] = (bf16_t)(b & 0xffffu); vp[3 * (size_t)ldv] = (bf16_t)(b >> 16); } } asm volatile("" ::: "memory"); } }
    }
};

template <class Epi, class Sched, bool ALIGN_EPI = false, bool SP2 = false>
__device__ __forceinline__ void gemm_phase(PG8_LAS unsigned char* lds, const Gemm g, const Sched& S, const Epi& E) {
    const int tid = otid(), wid = __builtin_amdgcn_readfirstlane(tid >> 6), lane = tid & 63, wr = wid >> 2, wc = wid & 3, fr = lane & 15, fq = lane >> 4;
    const int K = g.K, nt = K / BK;
    unsigned voffA[2], voffB[2];
#pragma unroll
    for (int i = 0; i < 2; ++i) { int R, C; stage_rc(tid * 16 + i * 8192, R, C); const int Rb = Epi::PERM ? ((R & ~31) + perm32(R & 31)) : R;
        voffA[i] = (unsigned)(R * g.lda + C) * 2u; voffB[i] = (unsigned)(Rb * g.ldb + C) * 2u; }
    const size_t kstep = (size_t)(BK * 2);
    const size_t hstepA = (size_t)HALF * g.lda * 2, hstepB = (size_t)HALF * g.ldb * 2;
    const size_t tstepA = 2 * hstepA, tstepB = 2 * hstepB;
    const unsigned ldsw = (unsigned)wid * 1024u;
    const int aoff = lds_byte(wr * 64 + fr, fq * 8), boff = lds_byte(wc * 32 + fr, fq * 8);
#define PG8_SA(b, h) (((b) * 2 + (h)) * HTB)
#define PG8_SB(b, h) ((4 + (b) * 2 + (h)) * HTB)
#define PG8_STAGE(bufoff, gbase, voff) do { _Pragma("unroll") for (int _i = 0; _i < 2; ++_i) \
        __builtin_amdgcn_global_load_lds((const unsigned*)((const char*)(gbase) + (voff)[_i]), (PG8_LAS unsigned*)(lds + (bufoff) + ldsw + _i * 8192), 16, 0, 0); } while (0)
#define PG8_LDA(dst, b, h) do { _Pragma("unroll") for (int m = 0; m < 4; ++m) _Pragma("unroll") for (int k = 0; k < 2; ++k) dst[m][k] = *(const PG8_LAS bf16x8*)(lds + PG8_SA(b, h) + aoff + m * 2048 + k * 1024); } while (0)
#define PG8_LDB(dst, b, h) do { _Pragma("unroll") for (int n = 0; n < 2; ++n) _Pragma("unroll") for (int k = 0; k < 2; ++k) dst[n][k] = *(const PG8_LAS bf16x8*)(lds + PG8_SB(b, h) + boff + n * 2048 + k * 1024); } while (0)
#define PG8_MMA(ai, bj, At, Bt) do { __builtin_amdgcn_s_setprio(1); _Pragma("unroll") for (int m = 0; m < 4; ++m) _Pragma("unroll") for (int n = 0; n < 2; ++n) _Pragma("unroll") for (int k = 0; k < 2; ++k) \
        acc[ai][bj][m][n] = __builtin_amdgcn_mfma_f32_16x16x32_bf16(Bt[n][k], At[m][k], acc[ai][bj][m][n], 0, 0, 0); __builtin_amdgcn_s_setprio(0); } while (0)
#define PG8_WAIT_V(n) asm volatile("s_waitcnt vmcnt(" #n ")" ::: "memory")
#define PG8_WAIT_L(n) asm volatile("s_waitcnt lgkmcnt(" #n ")" ::: "memory")
#define PG8_BAR __builtin_amdgcn_s_barrier()
#define PG8_SCHED __builtin_amdgcn_sched_barrier(0)
    Unit cur, nxt; int ui = 0;
    if (!S.next(0, cur)) return;
    f32x4 acc[2][2][4][2];
#pragma unroll
    for (int a = 0; a < 2; ++a)
#pragma unroll
        for (int b = 0; b < 2; ++b)
#pragma unroll
            for (int m = 0; m < 4; ++m)
#pragma unroll
                for (int n = 0; n < 2; ++n) acc[a][b][m][n] = (f32x4){0.f, 0.f, 0.f, 0.f};
    bf16x8 At[4][2], B0[2][2], B1[2][2];
    const char* cA = (const char*)g.A + (size_t)cur.pm * tstepA; const char* cB = (const char*)g.Bt + (size_t)cur.pn * tstepB;
    S.a_ready(cur);
    if constexpr (SP2) {
        PG8_STAGE(PG8_SB(0, 0), cB, voffB); PG8_STAGE(PG8_SB(0, 1), cB + hstepB, voffB); PG8_STAGE(PG8_SA(0, 0), cA, voffA); PG8_STAGE(PG8_SA(0, 1), cA + hstepA, voffA);
        if (wr == 1) PG8_BAR;
        PG8_WAIT_V(2); PG8_BAR;
        PG8_STAGE(PG8_SB(1, 0), cB + kstep, voffB); PG8_STAGE(PG8_SA(1, 0), cA + kstep, voffA); PG8_STAGE(PG8_SB(1, 1), cB + hstepB + kstep, voffB);
        PG8_WAIT_V(6); PG8_BAR;
    } else {
        PG8_STAGE(PG8_SB(0, 0), cB, voffB); PG8_STAGE(PG8_SA(0, 0), cA, voffA); PG8_STAGE(PG8_SB(0, 1), cB + hstepB, voffB); PG8_STAGE(PG8_SA(0, 1), cA + hstepA, voffA);
        if (wr == 1) PG8_BAR;
        PG8_WAIT_V(4); PG8_BAR;
        PG8_STAGE(PG8_SB(1, 0), cB + kstep, voffB); PG8_STAGE(PG8_SA(1, 0), cA + kstep, voffA); PG8_STAGE(PG8_SB(1, 1), cB + hstepB + kstep, voffB);
        PG8_WAIT_V(6); PG8_BAR;
    }
    for (;;) {
        const bool has_next = S.next(ui + 1, nxt);
        const char* nA = has_next ? (const char*)g.A + (size_t)nxt.pm * tstepA : cA; const char* nB = has_next ? (const char*)g.Bt + (size_t)nxt.pn * tstepB : cB;
#pragma unroll 1
        for (int t = 0; t < nt; t += 2) {
            const bool last = (t == nt - 2);
            const char* a1 = cA + (size_t)(t + 1) * kstep;
            const char* a2 = last ? nA : cA + (size_t)(t + 2) * kstep; const char* b2 = last ? nB : cB + (size_t)(t + 2) * kstep;
            const char* a3 = a2 + kstep; const char* b3 = b2 + kstep;
            if (last && has_next) S.a_ready(nxt);
            if constexpr (SP2) {
            PG8_LDB(B0, 0, 0); PG8_LDB(B1, 0, 1); PG8_SCHED; PG8_LDA(At, 0, 0); PG8_STAGE(PG8_SA(1, 1), a1 + hstepA, voffA);
            PG8_WAIT_V(8); PG8_WAIT_L(0); PG8_BAR; PG8_MMA(0, 0, At, B0); PG8_MMA(0, 1, At, B1); PG8_BAR; PG8_SCHED;
            PG8_LDA(At, 0, 1); PG8_STAGE(PG8_SB(0, 0), b2, voffB); PG8_STAGE(PG8_SB(0, 1), b2 + hstepB, voffB); PG8_STAGE(PG8_SA(0, 0), a2, voffA);
            PG8_WAIT_V(8); PG8_WAIT_L(0); PG8_BAR; PG8_MMA(1, 0, At, B0); PG8_MMA(1, 1, At, B1); PG8_BAR; PG8_SCHED;
            PG8_LDB(B0, 1, 0); PG8_LDB(B1, 1, 1); PG8_SCHED; PG8_LDA(At, 1, 0); PG8_STAGE(PG8_SA(0, 1), a2 + hstepA, voffA);
            PG8_WAIT_V(8); PG8_WAIT_L(0); PG8_BAR; PG8_MMA(0, 0, At, B0); PG8_MMA(0, 1, At, B1); PG8_BAR; PG8_SCHED;
            PG8_LDA(At, 1, 1); PG8_STAGE(PG8_SB(1, 0), b3, voffB); PG8_STAGE(PG8_SB(1, 1), b3 + hstepB, voffB); PG8_STAGE(PG8_SA(1, 0), a3, voffA);
            PG8_WAIT_V(8); PG8_WAIT_L(0); PG8_BAR; PG8_MMA(1, 0, At, B0); PG8_MMA(1, 1, At, B1); PG8_BAR; PG8_SCHED;
            } else {
            PG8_LDB(B0, 0, 0); PG8_SCHED; PG8_LDA(At, 0, 0); PG8_STAGE(PG8_SA(1, 1), a1 + hstepA, voffA);
            PG8_WAIT_L(8); PG8_BAR; PG8_WAIT_L(0); PG8_MMA(0, 0, At, B0); PG8_BAR; PG8_SCHED;
            PG8_LDB(B1, 0, 1); PG8_STAGE(PG8_SB(0, 0), b2, voffB);
            PG8_BAR; PG8_WAIT_L(0); PG8_MMA(0, 1, At, B1); PG8_BAR;
            PG8_LDA(At, 0, 1); PG8_STAGE(PG8_SA(0, 0), a2, voffA);
            PG8_BAR; PG8_WAIT_L(0); PG8_MMA(1, 0, At, B0); PG8_BAR; PG8_SCHED;
            PG8_STAGE(PG8_SB(0, 1), b2 + hstepB, voffB);
            PG8_WAIT_V(6); PG8_BAR; PG8_MMA(1, 1, At, B1); PG8_BAR;
            PG8_LDB(B0, 1, 0); PG8_SCHED; PG8_LDA(At, 1, 0); PG8_STAGE(PG8_SA(0, 1), a2 + hstepA, voffA);
            PG8_WAIT_L(8); PG8_BAR; PG8_WAIT_L(0); PG8_MMA(0, 0, At, B0); PG8_BAR; PG8_SCHED;
            PG8_LDB(B1, 1, 1); PG8_STAGE(PG8_SB(1, 0), b3, voffB);
            PG8_BAR; PG8_WAIT_L(0); PG8_MMA(0, 1, At, B1); PG8_BAR;
            PG8_LDA(At, 1, 1); PG8_STAGE(PG8_SA(1, 0), a3, voffA);
            PG8_BAR; PG8_WAIT_L(0); PG8_MMA(1, 0, At, B0); PG8_BAR; PG8_SCHED;
            PG8_STAGE(PG8_SB(1, 1), b3 + hstepB, voffB);
            PG8_WAIT_V(6); PG8_BAR; PG8_MMA(1, 1, At, B1); PG8_BAR;
            }
        }
        if constexpr (ALIGN_EPI) { if (wr == 0) PG8_BAR; }
        if constexpr (!Epi::AFTER_DRAIN) { E(acc, cur, wr, wc, fr, fq); S.done(cur); }
        if (!has_next) break;
#pragma unroll
        for (int a = 0; a < 2; ++a)
#pragma unroll
            for (int b = 0; b < 2; ++b)
#pragma unroll
                for (int m = 0; m < 4; ++m)
#pragma unroll
                    for (int n = 0; n < 2; ++n) acc[a][b][m][n] = (f32x4){0.f, 0.f, 0.f, 0.f};
        cur = nxt; cA = nA; cB = nB; ++ui;
        if constexpr (ALIGN_EPI) { if (wr == 1) PG8_BAR; }
    }
    PG8_WAIT_V(0);
    if constexpr (!ALIGN_EPI) { if (wr == 0) PG8_BAR; }
    PG8_BAR;
    if constexpr (Epi::AFTER_DRAIN) { E.fused(acc, cur, wr, wc, fr, fq, lds, wid, lane); S.done(cur); }
#undef PG8_SA
#undef PG8_SB
#undef PG8_STAGE
#undef PG8_LDA
#undef PG8_LDB
#undef PG8_MMA
#undef PG8_WAIT_V
#undef PG8_WAIT_L
#undef PG8_BAR
#undef PG8_SCHED
}
}

using pg8::bf16_t; using pg8::bf16x8; using pg8::f32x4; using pg8::u32x4; using pg8::f32x2; using pg8::u32x2; using pg8::pk2; using pg8::bflo; using pg8::bfhi;
typedef float f32x16 __attribute__((ext_vector_type(16)));
#define LAS __attribute__((address_space(3)))
constexpr int DM = 1024, SEQL = 8192, NTOK = 4 * SEQL, TH = NTOK / 2, NLAYER = 2, INW = 9144, NP = 5120, DFF = 4096;
constexpr int C_Z = 0, C_XBC = 512, C_DT = 1536, C_RQ = 1544, C_RK = 1800, C_RV = 2056, C_RG = 2568, C_CQ = 3080, C_CKV = 3336, C_KR = 3464,
              C_GQ = 3496, C_GK = 3752, C_GV = 4008, C_GGK = 4520, C_GG = 4536, C_GATE = 5048;
constexpr float EPS = 1e-6f;
constexpr int NCH = SEQL / 64;
constexpr size_t MiB = 1024 * 1024;
constexpr size_t WS_WIN = 0, WS_WG = WS_WIN + 10 * MiB, WS_W1 = WS_WG + 8 * MiB, WS_W2 = WS_W1 + 8 * MiB, WS_WB = WS_W2 + 8 * MiB, WS_WO = WS_WB + 4 * MiB,
                 WS_WUQ = WS_WO + 2 * MiB, WS_WUKV = WS_WUQ + 512 * 1024, WS_ROPER = WS_WUKV + 512 * 1024, WS_ROPEM = WS_ROPER + 8 * MiB, WS_HN = WS_ROPEM + 4 * MiB,
                 WS_PROJ = WS_HN + 32 * MiB, WS_XBCC = WS_PROJ + 160 * MiB, WS_QM = WS_XBCC + 32 * MiB, WS_KN = WS_QM + 24 * MiB, WS_VT = WS_KN + 16 * MiB,
                 WS_ST0 = WS_VT + 16 * MiB, WS_ST1 = WS_ST0 + 32 * MiB, WS_ST2 = WS_ST1 + 16 * MiB, WS_YS = WS_ST2 + 16 * MiB, WS_DTT = WS_YS + 64 * MiB,
                 WS_CUMT = WS_DTT + 512 * 1024, WS_GTOT = WS_CUMT + 512 * 1024, WS_RSQ = WS_GTOT + 256 * 1024, WS_RSKV = WS_RSQ + 64 * 1024, WS_SSQ = WS_RSKV + 64 * 1024,
                 WS_KVR = WS_SSQ + 1 * MiB, WS_END = WS_KVR + 32 * MiB;
constexpr size_t WS_GATES = WS_PROJ, WS_MERGED = WS_PROJ + 128 * MiB, WS_U = WS_PROJ, WS_T = WS_XBCC;

struct KP {
    const float* x; const int* pos; const float* w_in; const float* b_gate; const float* conv_w; const float* conv_b; const float* dt_bias; const float* a_log; const float* ssd_d;
    const float* ssd_norm; const float* ret_norm; const float* mla_q_norm; const float* w_uq; const float* mla_kv_norm; const float* w_ukv; const float* w_gk2; const float* b_gk;
    const float* gla_norm; const float* w_branch; const float* w_out; const float* n_pre_mix; const float* n_post_mix; const float* n_pre_mlp; const float* n_post_mlp;
    const float* w_mlp_in; const float* w_mlp_out; float* out; unsigned char* ws;
};

DI float silu_f(float x) { return x / (1.0f + __expf(-x)); }
DI float softplus_f(float x) { return x > 20.f ? x : log1pf(__expf(x)); }
DI float logsigmoid_f(float x) { return fminf(x, 0.f) - log1pf(__expf(-fabsf(x))); }
DI int crow(int r, int hi) { return (r & 3) + 8 * (r >> 2) + 4 * hi; }
DI void unpack8(const u32x4 v, float* f) { f[0] = bflo(v.x); f[1] = bfhi(v.x); f[2] = bflo(v.y); f[3] = bfhi(v.y); f[4] = bflo(v.z); f[5] = bfhi(v.z); f[6] = bflo(v.w); f[7] = bfhi(v.w); }
DI u32x4 pack8(const float* f) { u32x4 w; w.x = pk2(f[0], f[1]); w.y = pk2(f[2], f[3]); w.z = pk2(f[4], f[5]); w.w = pk2(f[6], f[7]); return w; }
DI bf16_t f2bf(float x) { return (bf16_t)(pk2(x, 0.f) & 0xffffu); }
DI float bf2f(bf16_t h) { return __uint_as_float((unsigned)h << 16); }
DI float wave_sum(float v) {
#pragma unroll
    for (int o = 1; o < 64; o <<= 1) v += __shfl_xor(v, o);
    return v;
}
DI float half_sum32(float v) {
#pragma unroll
    for (int o = 1; o < 32; o <<= 1) v += __shfl_xor(v, o);
    return v;
}
#define MFMA32(a, b, c) __builtin_amdgcn_mfma_f32_32x32x16_bf16((a), (b), (c), 0, 0, 0)
DI f32x16 zero16() { f32x16 z;
#pragma unroll
    for (int i = 0; i < 16; ++i) z[i] = 0.f;
    return z; }

DI void wt_item(const float* W, int ldw, int c0, int ncols, const float* gk, bf16_t* WT, int K, int npad, int item, LAS float* scr, int lane) {
    const int nblk = npad / 32, kb = item / nblk, nb = item % nblk, k0 = 64 * kb, n0 = 32 * nb;
#pragma unroll 8
    for (int i = 0; i < 32; ++i) { const int kk = 2 * i + (lane >> 5), n = n0 + (lane & 31);
        float v = (n < ncols) ? W[(size_t)(k0 + kk) * ldw + c0 + n] : 0.f;
        if (gk) v *= gk[k0 + kk];
        scr[kk * 33 + (lane & 31)] = v; }
    __builtin_amdgcn_s_waitcnt(0xc07f); asm volatile("" ::: "memory");
    const int c = lane & 7;
#pragma unroll
    for (int j = 0; j < 4; ++j) { const int n = (lane >> 3) + 8 * j; const LAS float* s = scr + (8 * c) * 33 + n;
        u32x4 o; o.x = pk2(s[0 * 33], s[1 * 33]); o.y = pk2(s[2 * 33], s[3 * 33]); o.z = pk2(s[4 * 33], s[5 * 33]); o.w = pk2(s[6 * 33], s[7 * 33]);
        *(u32x4*)(WT + (size_t)(n0 + n) * K + k0 + 8 * c) = o; }
    __builtin_amdgcn_s_waitcnt(0xc07f); asm volatile("" ::: "memory");
}
DI void phase_weights(const KP& p, int ly, LAS unsigned char* lds) {
    const int tid = otid(), lane = tid & 63, wv = tid >> 6;
    LAS float* scr = (LAS float*)(lds + wv * 8704);
    const int gw = obid() * 8 + wv, NGW = gridDim.x * 8;
    unsigned char* ws = ows(p.ws);
    constexpr int I_IN = 16 * 160, I_G = 16 * 128, I_1 = 16 * 128, I_2 = 64 * 32, I_B = 8 * 32, I_O = 16 * 32, I_UQ = 4 * 24, I_UKV = 2 * 32;
    constexpr int NIT = I_IN + I_G + I_1 + I_2 + 4 * I_B + I_O + I_UQ + I_UKV;
    for (int it = gw; it < NIT; it += NGW) {
        int r = it;
        if (r < I_IN) { wt_item(p.w_in + (size_t)ly * DM * INW, INW, 0, C_GATE, nullptr, (bf16_t*)(ws + WS_WIN), DM, NP, r, scr, lane); continue; } r -= I_IN;
        if (r < I_G) { wt_item(p.w_in + (size_t)ly * DM * INW, INW, C_GATE, 4096, nullptr, (bf16_t*)(ws + WS_WG), DM, 4096, r, scr, lane); continue; } r -= I_G;
        if (r < I_1) { wt_item(p.w_mlp_in + (size_t)ly * DM * DFF, DFF, 0, DFF, nullptr, (bf16_t*)(ws + WS_W1), DM, DFF, r, scr, lane); continue; } r -= I_1;
        if (r < I_2) { wt_item(p.w_mlp_out + (size_t)ly * DFF * DM, DM, 0, DM, nullptr, (bf16_t*)(ws + WS_W2), DFF, DM, r, scr, lane); continue; } r -= I_2;
        if (r < 4 * I_B) { const int br = r / I_B; wt_item(p.w_branch + ((size_t)ly * 4 + br) * 512 * DM, DM, 0, DM, br == 0 ? p.ssd_norm + ly * 512 : nullptr,
                                                          (bf16_t*)(ws + WS_WB) + (size_t)br * DM * 512, 512, DM, r % I_B, scr, lane); continue; } r -= 4 * I_B;
        if (r < I_O) { wt_item(p.w_out + (size_t)ly * DM * DM, DM, 0, DM, nullptr, (bf16_t*)(ws + WS_WO), DM, DM, r, scr, lane); continue; } r -= I_O;
        if (r < I_UQ) { wt_item(p.w_uq + (size_t)ly * 256 * 768, 768, 0, 768, p.mla_q_norm + ly * 256, (bf16_t*)(ws + WS_WUQ), 256, 768, r, scr, lane); continue; } r -= I_UQ;
        wt_item(p.w_ukv + (size_t)ly * 128 * 1024, 1024, 0, 1024, p.mla_kv_norm + ly * 128, (bf16_t*)(ws + WS_WUKV), 128, 1024, r, scr, lane);
    }
}
DI void phase_rope_tables(const KP& p) {
    const int gt = obid() * 512 + otid(), NT = gridDim.x * 512;
    f32x2* rr = (f32x2*)(ows(p.ws) + WS_ROPER); f32x2* rm = (f32x2*)(ows(p.ws) + WS_ROPEM);
    for (int i = gt; i < NTOK * 48; i += NT) {
        const int t = i / 48, f = i % 48;
        const int half = f < 32 ? 32 : 16, fi = f < 32 ? f : f - 32;
        const float inv = (float)exp2(-(double)fi / (double)half * 13.287712379549449);
        const float ang = (float)p.pos[t] * inv;
        double tr = (double)ang * 0.15915494309189535; tr -= rint(tr);
        const float trf = (float)tr;
        f32x2 cs; cs.x = __builtin_amdgcn_cosf(trf); cs.y = __builtin_amdgcn_sinf(trf);
        if (f < 32) rr[(size_t)t * 32 + fi] = cs; else rm[(size_t)t * 16 + fi] = cs;
    }
}
DI void phase_norm0(const KP& p, int ly, int hf) {
    const int lane = otid() & 63, gw = obid() * 8 + (otid() >> 6), NGW = gridDim.x * 8;
    const float* xin = (ly == 0 ? p.x : p.out) + (size_t)hf * TH * DM; const float* g = p.n_pre_mix + ly * DM;
    bf16_t* hn = (bf16_t*)(ows(p.ws) + WS_HN);
    for (int r = gw; r < TH; r += NGW) {
        const f32x4* xr = (const f32x4*)(xin + (size_t)r * DM) + lane; f32x4 v[4]; float s = 0.f;
#pragma unroll
        for (int j = 0; j < 4; ++j) { v[j] = xr[64 * j]; s += (v[j][0] * v[j][0] + v[j][1] * v[j][1]) + (v[j][2] * v[j][2] + v[j][3] * v[j][3]); }
        const float rs = rsqrtf(wave_sum(s) * (1.f / DM) + EPS);
        u32x2* o = (u32x2*)(hn + (size_t)r * DM) + lane;
#pragma unroll
        for (int j = 0; j < 4; ++j) { const f32x4 gg = ((const f32x4*)g)[lane + 64 * j]; u32x2 w; w.x = pk2(v[j][0] * rs * gg[0], v[j][1] * rs * gg[1]); w.y = pk2(v[j][2] * rs * gg[2], v[j][3] * rs * gg[3]); o[64 * j] = w; }
    }
}
DI void phase_norm_res(const KP& p, int hf, const float* xin_base, const float* g1, const float* g2) {
    const int lane = otid() & 63, gw = obid() * 8 + (otid() >> 6), NGW = gridDim.x * 8;
    const float* xin = xin_base + (size_t)hf * TH * DM; float* xo = p.out + (size_t)hf * TH * DM;
    const bf16_t* tb = (const bf16_t*)(ows(p.ws) + WS_T); bf16_t* hn = (bf16_t*)(ows(p.ws) + WS_HN);
    for (int r = gw; r < TH; r += NGW) {
        const u32x2* tr = (const u32x2*)(tb + (size_t)r * DM) + lane; f32x4 tv[4]; float s = 0.f;
#pragma unroll
        for (int j = 0; j < 4; ++j) { const u32x2 w = tr[64 * j]; tv[j][0] = bflo(w.x); tv[j][1] = bfhi(w.x); tv[j][2] = bflo(w.y); tv[j][3] = bfhi(w.y);
            s += (tv[j][0] * tv[j][0] + tv[j][1] * tv[j][1]) + (tv[j][2] * tv[j][2] + tv[j][3] * tv[j][3]); }
        const float rs = rsqrtf(wave_sum(s) * (1.f / DM) + EPS);
        const f32x4* xr = (const f32x4*)(xin + (size_t)r * DM) + lane; f32x4* orow = (f32x4*)(xo + (size_t)r * DM) + lane; float s2 = 0.f;
#pragma unroll
        for (int j = 0; j < 4; ++j) { const f32x4 gg = ((const f32x4*)g1)[lane + 64 * j]; const f32x4 xv = xr[64 * j];
            tv[j] = xv + tv[j] * rs * gg; orow[64 * j] = tv[j];
            s2 += (tv[j][0] * tv[j][0] + tv[j][1] * tv[j][1]) + (tv[j][2] * tv[j][2] + tv[j][3] * tv[j][3]); }
        if (g2) {
            const float rs2 = rsqrtf(wave_sum(s2) * (1.f / DM) + EPS);
            u32x2* o = (u32x2*)(hn + (size_t)r * DM) + lane;
#pragma unroll
            for (int j = 0; j < 4; ++j) { const f32x4 gg = ((const f32x4*)g2)[lane + 64 * j]; u32x2 w; w.x = pk2(tv[j][0] * rs2 * gg[0], tv[j][1] * rs2 * gg[1]); w.y = pk2(tv[j][2] * rs2 * gg[2], tv[j][3] * rs2 * gg[3]); o[64 * j] = w; }
        }
    }
}

DI float ret_loggamma(int h) { return log1pf(-exp2f(-5.0f - (float)h)); }
DI void phase_prep(const KP& p, int ly, int hf) {
    const int tid = otid(), lane = tid & 63, wv = tid >> 6;
    const int gt = obid() * 512 + tid, NT = gridDim.x * 512, gw = obid() * 8 + wv, NGW = gridDim.x * 8;
    bf16_t* proj = (bf16_t*)(ows(p.ws) + WS_PROJ); bf16_t* xbcc = (bf16_t*)(ows(p.ws) + WS_XBCC);
    { const float* cw = p.conv_w + (size_t)ly * 4 * 1024; const float* cb = p.conv_b + (size_t)ly * 1024;
      for (int i = gt; i < TH * 128; i += NT) { const int t = i >> 7, c8 = (i & 127) * 8, l = t & (SEQL - 1);
        float a[8];
#pragma unroll
        for (int e = 0; e < 8; ++e) a[e] = cb[c8 + e];
#pragma unroll
        for (int j = 0; j < 4; ++j) { if (l - 3 + j >= 0) { float xv[8]; unpack8(*(const u32x4*)(proj + (size_t)(t - 3 + j) * NP + C_XBC + c8), xv);
#pragma unroll
            for (int e = 0; e < 8; ++e) a[e] += cw[j * 1024 + c8 + e] * xv[e]; } }
#pragma unroll
        for (int e = 0; e < 8; ++e) a[e] = silu_f(a[e]);
        *(u32x4*)(xbcc + (size_t)t * 1024 + c8) = pack8(a); } }
    { float* dtT = (float*)(ows(p.ws) + WS_DTT); float* cumT = (float*)(ows(p.ws) + WS_CUMT);
      for (int it = gw; it < (TH / 64) * 8; it += NGW) { const int ch = it >> 3, h = it & 7, t = ch * 64 + lane;
        const float dt = softplus_f(bf2f(proj[(size_t)t * NP + C_DT + h]) + p.dt_bias[ly * 8 + h]);
        float a = -__expf(p.a_log[ly * 8 + h]) * dt;
#pragma unroll
        for (int o = 1; o < 64; o <<= 1) { const float y = __shfl_up(a, o); if (lane >= o) a += y; }
        dtT[(size_t)h * TH + t] = dt; cumT[(size_t)h * TH + t] = a; } }
    { const f32x2* rr = (const f32x2*)(ows(p.ws) + WS_ROPER) + (size_t)hf * TH * 32;
      for (int i = gt; i < TH * 32; i += NT) { const int t = i >> 5, r = i & 31, which = r >> 4, h = (r >> 2) & 3, g = r & 3;
        bf16_t* base = proj + (size_t)t * NP + (which ? C_RK : C_RQ) + h * 64 + 8 * g; const float sc = which ? 0.125f : 1.0f;
        float x1[8], x2[8], o1[8], o2[8]; unpack8(*(const u32x4*)base, x1); unpack8(*(const u32x4*)(base + 32), x2);
#pragma unroll
        for (int e = 0; e < 8; ++e) { const f32x2 cs = rr[(size_t)t * 32 + 8 * g + e]; o1[e] = (x1[e] * cs.x - x2[e] * cs.y) * sc; o2[e] = (x2[e] * cs.x + x1[e] * cs.y) * sc; }
        *(u32x4*)base = pack8(o1); *(u32x4*)(base + 32) = pack8(o2); } }
    { const f32x2* rm = (const f32x2*)(ows(p.ws) + WS_ROPEM) + (size_t)hf * TH * 16;
      for (int i = gt; i < TH * 2; i += NT) { const int t = i >> 1, g = i & 1; bf16_t* base = proj + (size_t)t * NP + C_KR + 8 * g;
        float x1[8], x2[8], o1[8], o2[8]; unpack8(*(const u32x4*)base, x1); unpack8(*(const u32x4*)(base + 16), x2);
#pragma unroll
        for (int e = 0; e < 8; ++e) { const f32x2 cs = rm[(size_t)t * 16 + 8 * g + e]; o1[e] = x1[e] * cs.x - x2[e] * cs.y; o2[e] = x2[e] * cs.x + x1[e] * cs.y; }
        *(u32x4*)base = pack8(o1); *(u32x4*)(base + 16) = pack8(o2); } }
    { float* rsq = (float*)(ows(p.ws) + WS_RSQ); float* rskv = (float*)(ows(p.ws) + WS_RSKV);
      for (int it = gw; it < TH / 2; it += NGW) { const int row = it * 2 + (lane >> 5); float xv[8]; unpack8(*(const u32x4*)(proj + (size_t)row * NP + C_CQ + 8 * (lane & 31)), xv);
        float s = 0.f;
#pragma unroll
        for (int e = 0; e < 8; ++e) s += xv[e] * xv[e];
        s = half_sum32(s); if ((lane & 31) == 0) rsq[row] = rsqrtf(s * (1.f / 256.f) + EPS); }
      for (int it = gw; it < TH / 4; it += NGW) { const int row = it * 4 + (lane >> 4); float xv[8]; unpack8(*(const u32x4*)(proj + (size_t)row * NP + C_CKV + 8 * (lane & 15)), xv);
        float s = 0.f;
#pragma unroll
        for (int e = 0; e < 8; ++e) s += xv[e] * xv[e];
#pragma unroll
        for (int o = 1; o < 16; o <<= 1) s += __shfl_xor(s, o);
        if ((lane & 15) == 0) rskv[row] = rsqrtf(s * (1.f / 128.f) + EPS); } }
    { float* gtot = (float*)(ows(p.ws) + WS_GTOT); const float* w2 = p.w_gk2 + (size_t)ly * 16 * 256; const float* bb = p.b_gk + ly * 256;
      for (int it = gw; it < (TH / 64) * 4; it += NGW) { const int ch = it >> 2, h = it & 3, c = h * 64 + lane;
        float w[16];
#pragma unroll
        for (int r = 0; r < 16; ++r) w[r] = w2[r * 256 + c];
        const float b0 = bb[c]; float run = 0.f;
        for (int j = 0; j < 64; ++j) { const size_t t = (size_t)ch * 64 + j; bf16_t* row = proj + t * NP;
            float gl[16]; unpack8(*(const u32x4*)(row + C_GGK), gl); unpack8(*(const u32x4*)(row + C_GGK + 8), gl + 8);
            float xg = b0;
#pragma unroll
            for (int r = 0; r < 16; ++r) xg += gl[r] * w[r];
            run += logsigmoid_f(xg) * (1.0f / 16.0f);
            const float e = __expf(run);
            row[C_GQ + c] = f2bf(bf2f(row[C_GQ + c]) * 0.125f * e);
            row[C_GK + c] = f2bf(bf2f(row[C_GK + c]) / e); }
        gtot[(size_t)ch * 256 + c] = run; } }
}

template <int MIX> struct MixC { static constexpr int H = MIX == 0 ? 8 : 4, DK = MIX == 0 ? 128 : 64, DV = MIX == 0 ? 64 : 128; };
constexpr int LS = 72;
template <int MIX> DI bf16_t* st_base(const KP& p) { return (bf16_t*)(ows(p.ws) + (MIX == 0 ? WS_ST0 : MIX == 1 ? WS_ST1 : WS_ST2)); }
template <int MIX> DI const bf16_t* v_src(const KP& p, int h, size_t t) {
    return MIX == 0 ? (const bf16_t*)(ows(p.ws) + WS_XBCC) + t * 1024 + h * 64 : (const bf16_t*)(ows(p.ws) + WS_PROJ) + t * NP + (MIX == 1 ? C_RV : C_GV) + h * 128; }
template <int MIX> DI const bf16_t* k_src(const KP& p, int h, size_t t) {
    return MIX == 0 ? (const bf16_t*)(ows(p.ws) + WS_XBCC) + t * 1024 + 512 + (h >> 2) * 128 : (const bf16_t*)(ows(p.ws) + WS_PROJ) + t * NP + (MIX == 1 ? C_RK : C_GK) + h * 64; }
template <int MIX> DI const bf16_t* q_src(const KP& p, int h, size_t t) {
    return MIX == 0 ? (const bf16_t*)(ows(p.ws) + WS_XBCC) + t * 1024 + 768 + (h >> 2) * 128 : (const bf16_t*)(ows(p.ws) + WS_PROJ) + t * NP + (MIX == 1 ? C_RQ : C_GQ) + h * 64; }
template <int W, class SRC, class SCL> DI void stage_T(LAS bf16_t* img, int tid, SRC src, SCL scl) {
#pragma unroll
    for (int i = 0; i < W / 64; ++i) { const int idx = tid + 512 * i, tok = idx / (W / 8), ch = 8 * (idx % (W / 8));
        float v[8]; unpack8(*(const u32x4*)(src(tok) + ch), v); const float s = scl(tok);
#pragma unroll
        for (int e = 0; e < 8; ++e) img[(ch + e) * LS + tok] = f2bf(v[e] * s); }
}
template <int MIX> DI void pass1_item(const KP& p, int item, LAS unsigned char* lds) {
    constexpr int H = MixC<MIX>::H, DK = MixC<MIX>::DK, DV = MixC<MIX>::DV;
    const int tid = otid(), lane = tid & 63, wv = tid >> 6, l32 = lane & 31, hi = lane >> 5;
    const int c = item & 127, h = (item >> 7) % H, b = item / (128 * H); const size_t t0 = (size_t)b * SEQL + c * 64;
    LAS bf16_t* VtL = (LAS bf16_t*)lds; LAS bf16_t* KtL = VtL + DV * LS;
    const float* dtT = (const float*)(ows(p.ws) + WS_DTT) + (size_t)h * TH; const float* cumT = (const float*)(ows(p.ws) + WS_CUMT) + (size_t)h * TH;
    const float clast = MIX == 0 ? cumT[t0 + 63] : 0.f, lgam = MIX == 1 ? ret_loggamma(h) : 0.f;
    stage_T<DV>(VtL, tid, [&](int tok) { return v_src<MIX>(p, h, t0 + tok); },
                [&](int tok) { return MIX == 0 ? dtT[t0 + tok] * __expf(clast - cumT[t0 + tok]) : MIX == 1 ? __expf((float)(63 - tok) * lgam) : 1.0f; });
    stage_T<DK>(KtL, tid, [&](int tok) { return k_src<MIX>(p, h, t0 + tok); }, [&](int) { return 1.0f; });
    __syncthreads();
    constexpr int NTN = DK / 32; const int mv = wv / NTN, nk = wv % NTN;
    f32x16 acc = zero16();
#pragma unroll
    for (int ks = 0; ks < 4; ++ks) { const bf16x8 a = *(const LAS bf16x8*)(VtL + (32 * mv + l32) * LS + 16 * ks + 8 * hi), bq = *(const LAS bf16x8*)(KtL + (32 * nk + l32) * LS + 16 * ks + 8 * hi);
        acc = MFMA32(a, bq, acc); }
    bf16_t* St = st_base<MIX>(p) + (size_t)item * (DV * DK);
#pragma unroll
    for (int r = 0; r < 16; ++r) St[(32 * mv + crow(r, hi)) * DK + 32 * nk + l32] = f2bf(acc[r]);
    __syncthreads();
}
DI void phase_scan(const KP& p) {
    const int NT = gridDim.x * 512;
    for (int i = obid() * 512 + otid(); i < 131072; i += NT) {
        int mix, r = i; if (r < 65536) mix = 0; else if (r < 98304) { mix = 1; r -= 65536; } else { mix = 2; r -= 98304; }
        const int bh = r >> 12, e = r & 4095; const int H = mix == 0 ? 8 : 4, DKh = mix == 0 ? 64 : 32;
        const int b = bh / H, h = bh % H, dkp = e % DKh;
        unsigned* S = (unsigned*)(ows(p.ws) + (mix == 0 ? WS_ST0 : mix == 1 ? WS_ST1 : WS_ST2)) + (size_t)bh * 128 * 4096 + e;
        const float* cumT = (const float*)(ows(p.ws) + WS_CUMT) + (size_t)h * TH + (size_t)b * SEQL;
        const f32x2* gt = (const f32x2*)((const float*)(ows(p.ws) + WS_GTOT) + (size_t)b * NCH * 256 + h * 64) + dkp;
        const float dret = __expf(64.f * ret_loggamma(h));
        float r0 = 0.f, r1 = 0.f;
        for (int c0 = 0; c0 < NCH; c0 += 8) {
            unsigned v[8]; float d0[8], d1[8];
#pragma unroll
            for (int k = 0; k < 8; ++k) { v[k] = S[(size_t)(c0 + k) * 4096];
                if (mix == 0) { d0[k] = __expf(cumT[(c0 + k) * 64 + 63]); d1[k] = d0[k]; }
                else if (mix == 1) { d0[k] = dret; d1[k] = dret; }
                else { const f32x2 g = gt[(size_t)(c0 + k) * 128]; d0[k] = __expf(g.x); d1[k] = __expf(g.y); } }
#pragma unroll
            for (int k = 0; k < 8; ++k) { S[(size_t)(c0 + k) * 4096] = pk2(r0, r1);
                if (mix == 2) { r0 = d0[k] * (r0 + bflo(v[k])); r1 = d1[k] * (r1 + bfhi(v[k])); } else { r0 = d0[k] * r0 + bflo(v[k]); r1 = d1[k] * r1 + bfhi(v[k]); } }
        }
    }
}
template <int MIX> DI void pass3_item(const KP& p, int ly, int item, LAS unsigned char* lds) {
    constexpr int H = MixC<MIX>::H, DK = MixC<MIX>::DK, DV = MixC<MIX>::DV; constexpr bool SEG = MIX != 2;
    const int tid = otid(), lane = tid & 63, wv = tid >> 6, l32 = lane & 31, hi = lane >> 5;
    const int c = item & 127, h = (item >> 7) % H, b = item / (128 * H); const size_t t0 = (size_t)b * SEQL + c * 64;
    LAS bf16_t* PL = (LAS bf16_t*)lds; LAS bf16_t* VtL = PL + 64 * LS; LAS float* cumL = (LAS float*)(VtL + 128 * LS); LAS float* ssqL = cumL + 64;
    const float* dtT = (const float*)(ows(p.ws) + WS_DTT) + (size_t)h * TH; const float* cumT = (const float*)(ows(p.ws) + WS_CUMT) + (size_t)h * TH;
    stage_T<DV>(VtL, tid, [&](int tok) { return v_src<MIX>(p, h, t0 + tok); }, [&](int tok) { return MIX == 0 ? dtT[t0 + tok] : 1.0f; });
    if (tid < 64) cumL[tid] = MIX == 0 ? cumT[t0 + tid] : MIX == 1 ? (float)(tid + 1) * ret_loggamma(h) : 0.f;
    __syncthreads();
    if (wv < 4) { const int ti = wv >> 1, tj = wv & 1;
        if (tj <= ti) { f32x16 acc = zero16(); const bf16_t* qp = q_src<MIX>(p, h, t0 + 32 * ti + l32) + 8 * hi; const bf16_t* kp = k_src<MIX>(p, h, t0 + 32 * tj + l32) + 8 * hi;
#pragma unroll
            for (int ks = 0; ks < DK / 16; ++ks) acc = MFMA32(*(const bf16x8*)(qp + 16 * ks), *(const bf16x8*)(kp + 16 * ks), acc);
            const int j = 32 * tj + l32; const float cj = cumL[j];
#pragma unroll
            for (int r = 0; r < 16; ++r) { const int i = 32 * ti + crow(r, hi); float v = acc[r]; if (SEG) v *= __expf(fminf(cumL[i] - cj, 0.f)); if (j > i) v = 0.f; PL[i * LS + j] = f2bf(v); } } }
    __syncthreads();
    constexpr int NTN = DV / 32; const int ti = wv / NTN, tn = wv % NTN; const bool act = wv < 2 * NTN;
    f32x16 acc = zero16();
    if (act) {
        const bf16_t* qp = q_src<MIX>(p, h, t0 + 32 * ti + l32) + 8 * hi; const bf16_t* sp = st_base<MIX>(p) + (size_t)item * (DV * DK) + (32 * tn + l32) * DK + 8 * hi;
#pragma unroll
        for (int ks = 0; ks < DK / 16; ++ks) acc = MFMA32(*(const bf16x8*)(qp + 16 * ks), *(const bf16x8*)(sp + 16 * ks), acc);
        if (SEG) {
#pragma unroll
            for (int r = 0; r < 16; ++r) acc[r] *= __expf(cumL[32 * ti + crow(r, hi)]); }
#pragma unroll
        for (int ks = 0; ks < 4; ++ks) { if (ks < 2 || ti == 1) { const bf16x8 a = *(const LAS bf16x8*)(PL + (32 * ti + l32) * LS + 16 * ks + 8 * hi), bq = *(const LAS bf16x8*)(VtL + (32 * tn + l32) * LS + 16 * ks + 8 * hi);
            acc = MFMA32(a, bq, acc); } }
    }
    bf16_t* ys = (bf16_t*)(ows(p.ws) + WS_YS); const bf16_t* proj = (const bf16_t*)(ows(p.ws) + WS_PROJ); const int dv = 32 * tn + l32;
    if (MIX == 0) {
        if (act) { const bf16_t* xbcc = (const bf16_t*)(ows(p.ws) + WS_XBCC); float* ssq = (float*)(ows(p.ws) + WS_SSQ); const float dsk = p.ssd_d[ly * 8 + h];
#pragma unroll
            for (int r = 0; r < 16; ++r) { const size_t t = t0 + 32 * ti + crow(r, hi);
                float y = acc[r] + dsk * bf2f(xbcc[t * 1024 + h * 64 + dv]); y *= silu_f(bf2f(proj[t * NP + C_Z + h * 64 + dv]));
                const float s = half_sum32(y * y); if (l32 == 0) ssq[t * 16 + h * 2 + tn] = s;
                ys[t * 2048 + h * 64 + dv] = f2bf(y); } }
    } else {
#pragma unroll
        for (int r = 0; r < 16; ++r) { const float s = half_sum32(acc[r] * acc[r]); if (l32 == 0) ssqL[tn * 64 + 32 * ti + crow(r, hi)] = s; }
        __syncthreads();
        const float ng = (MIX == 1 ? p.ret_norm : p.gla_norm)[ly * 512 + h * 128 + dv];
#pragma unroll
        for (int r = 0; r < 16; ++r) { const int i = 32 * ti + crow(r, hi); const size_t t = t0 + i;
            const float tot = (ssqL[i] + ssqL[64 + i]) + (ssqL[128 + i] + ssqL[192 + i]); const float rs = rsqrtf(tot * (1.f / 128.f) + EPS);
            const float g = bf2f(proj[t * NP + (MIX == 1 ? C_RG : C_GG) + h * 128 + dv]);
            ys[t * 2048 + (MIX == 1 ? 512 : 1536) + h * 128 + dv] = f2bf(acc[r] * rs * ng * silu_f(g)); }
    }
    __syncthreads();
}

constexpr int KLS = 104, VLS = 72, ATT_KB = 64 * KLS * 2  , ATT_VB = 64 * VLS * 2  , ATT_BUF = ATT_KB + ATT_VB;
DI void attn_unit(const KP& p, int b, int h, int qb, LAS unsigned char* lds) {
    const int tid = otid(), lane = tid & 63, wv = tid >> 6, l32 = lane & 31, hi = lane >> 5;
    const bf16_t* QM = (const bf16_t*)(ows(p.ws) + WS_QM); const bf16_t* KN = (const bf16_t*)(ows(p.ws) + WS_KN); const bf16_t* VT = (const bf16_t*)(ows(p.ws) + WS_VT);
    const bf16_t* proj = (const bf16_t*)(ows(p.ws) + WS_PROJ); bf16_t* ys = (bf16_t*)(ows(p.ws) + WS_YS);
    const size_t tb = (size_t)b * SEQL; const int qloc0 = 256 * qb + 32 * wv, qloc = qloc0 + l32; const size_t tq = tb + qloc;
    bf16x8 qf[6];
#pragma unroll
    for (int s = 0; s < 6; ++s) qf[s] = *(const bf16x8*)(QM + tq * 768 + h * 96 + 16 * s + 8 * hi);
    f32x16 o0 = zero16(), o1 = zero16(); float mrun = -INFINITY, lsum = 0.f;
    const int nkt = 4 * qb + 4;
    const int k0key = tid / 12, k0c = tid % 12, k1id = tid + 512, k1key = k1id / 12, k1c = k1id % 12; const bool k1v = k1id < 768; const int vd = tid >> 3, vc = tid & 7;
    u32x4 rk0, rk1, rv;
#define ATT_LOAD(kt) do { const size_t tk = tb + 64 * (kt); \
        rk0 = (k0c < 8) ? *(const u32x4*)(KN + (tk + k0key) * 512 + h * 64 + 8 * k0c) : *(const u32x4*)(proj + (tk + k0key) * NP + C_KR + 8 * (k0c - 8)); \
        if (k1v) rk1 = (k1c < 8) ? *(const u32x4*)(KN + (tk + k1key) * 512 + h * 64 + 8 * k1c) : *(const u32x4*)(proj + (tk + k1key) * NP + C_KR + 8 * (k1c - 8)); \
        rv = *(const u32x4*)(VT + (size_t)(h * 64 + vd) * TH + tk + 8 * vc); } while (0)
#define ATT_STORE(buf) do { LAS unsigned char* B_ = lds + (buf) * ATT_BUF; \
        *(LAS u32x4*)(B_ + (k0key * KLS + 8 * k0c) * 2) = rk0; if (k1v) *(LAS u32x4*)(B_ + (k1key * KLS + 8 * k1c) * 2) = rk1; \
        *(LAS u32x4*)(B_ + ATT_KB + (vd * VLS + 8 * vc) * 2) = rv; } while (0)
    ATT_LOAD(0); ATT_STORE(0); __syncthreads();
    for (int kt = 0; kt < nkt; ++kt) {
        if (kt + 1 < nkt) ATT_LOAD(kt + 1);
        if (64 * kt <= qloc0 + 31) {
            const LAS bf16_t* KL = (const LAS bf16_t*)(lds + (kt & 1) * ATT_BUF); const LAS bf16_t* VL = (const LAS bf16_t*)(lds + (kt & 1) * ATT_BUF + ATT_KB);
            f32x16 s0 = zero16(), s1 = zero16();
#pragma unroll
            for (int s = 0; s < 6; ++s) { const bf16x8 ka = *(const LAS bf16x8*)(KL + l32 * KLS + 16 * s + 8 * hi), kb = *(const LAS bf16x8*)(KL + (32 + l32) * KLS + 16 * s + 8 * hi);
                s0 = MFMA32(ka, qf[s], s0); s1 = MFMA32(kb, qf[s], s1); }
            if (64 * kt + 63 > qloc0) {
#pragma unroll
                for (int r = 0; r < 16; ++r) { const int key = 64 * kt + crow(r, hi); if (key > qloc) s0[r] = -INFINITY; if (key + 32 > qloc) s1[r] = -INFINITY; } }
            float mx = fmaxf(s0[0], s1[0]);
#pragma unroll
            for (int r = 1; r < 16; ++r) mx = fmaxf(mx, fmaxf(s0[r], s1[r]));
            mx = fmaxf(mx, __shfl_xor(mx, 32));
            const float mnew = fmaxf(mrun, mx), alpha = exp2f(mrun - mnew); mrun = mnew;
            float ps = 0.f;
#pragma unroll
            for (int r = 0; r < 16; ++r) { s0[r] = exp2f(s0[r] - mnew); s1[r] = exp2f(s1[r] - mnew); ps += s0[r] + s1[r]; }
            lsum = lsum * alpha + ps;
#pragma unroll
            for (int r = 0; r < 16; ++r) { o0[r] *= alpha; o1[r] *= alpha; }
#pragma unroll
            for (int st = 0; st < 2; ++st)
#pragma unroll
                for (int t2 = 0; t2 < 2; ++t2) { u32x4 pw;
                    if (st == 0) { pw.x = pk2(s0[8 * t2], s0[8 * t2 + 1]); pw.y = pk2(s0[8 * t2 + 2], s0[8 * t2 + 3]); pw.z = pk2(s0[8 * t2 + 4], s0[8 * t2 + 5]); pw.w = pk2(s0[8 * t2 + 6], s0[8 * t2 + 7]); }
                    else { pw.x = pk2(s1[8 * t2], s1[8 * t2 + 1]); pw.y = pk2(s1[8 * t2 + 2], s1[8 * t2 + 3]); pw.z = pk2(s1[8 * t2 + 4], s1[8 * t2 + 5]); pw.w = pk2(s1[8 * t2 + 6], s1[8 * t2 + 7]); }
                    const bf16x8 pb = __builtin_bit_cast(bf16x8, pw); const int kof = 32 * st + 16 * t2 + 4 * hi;
                    { const u32x2 a0 = *(const LAS u32x2*)(VL + l32 * VLS + kof), a1 = *(const LAS u32x2*)(VL + l32 * VLS + kof + 8); u32x4 aw; aw.x = a0.x; aw.y = a0.y; aw.z = a1.x; aw.w = a1.y;
                      o0 = MFMA32(__builtin_bit_cast(bf16x8, aw), pb, o0); }
                    { const u32x2 a0 = *(const LAS u32x2*)(VL + (32 + l32) * VLS + kof), a1 = *(const LAS u32x2*)(VL + (32 + l32) * VLS + kof + 8); u32x4 aw; aw.x = a0.x; aw.y = a0.y; aw.z = a1.x; aw.w = a1.y;
                      o1 = MFMA32(__builtin_bit_cast(bf16x8, aw), pb, o1); } }
        }
        if (kt + 1 < nkt) ATT_STORE((kt + 1) & 1);
        __syncthreads();
    }
#undef ATT_LOAD
#undef ATT_STORE
    const float inv = 1.0f / (lsum + __shfl_xor(lsum, 32));
    bf16_t* op = ys + tq * 2048 + 1024 + h * 64 + 4 * hi;
#pragma unroll
    for (int g = 0; g < 4; ++g) { u32x2 w; w.x = pk2(o0[4 * g] * inv, o0[4 * g + 1] * inv); w.y = pk2(o0[4 * g + 2] * inv, o0[4 * g + 3] * inv); *(u32x2*)(op + 8 * g) = w;
        u32x2 w1; w1.x = pk2(o1[4 * g] * inv, o1[4 * g + 1] * inv); w1.y = pk2(o1[4 * g + 2] * inv, o1[4 * g + 3] * inv); *(u32x2*)(op + 32 + 8 * g) = w1; }
}

DI void phase_mla_fix(const KP& p, int hf, LAS unsigned char* lds) {
    const int tid = otid(), gt = obid() * 512 + tid, NT = gridDim.x * 512;
    bf16_t* QM = (bf16_t*)(ows(p.ws) + WS_QM); const bf16_t* KVR = (const bf16_t*)(ows(p.ws) + WS_KVR); bf16_t* KN = (bf16_t*)(ows(p.ws) + WS_KN); bf16_t* VT = (bf16_t*)(ows(p.ws) + WS_VT);
    const float* rsq = (const float*)(ows(p.ws) + WS_RSQ); const float* rskv = (const float*)(ows(p.ws) + WS_RSKV);
    const f32x2* rm = (const f32x2*)(ows(p.ws) + WS_ROPEM) + (size_t)hf * TH * 16;
    const float QSC = 0.14724445f;
    for (int i = gt; i < TH * 80; i += NT) { const int t = i / 80, r = i % 80, h = r / 10, g = r % 10; bf16_t* base = QM + (size_t)t * 768 + h * 96; const float sc = rsq[t] * QSC;
        if (g < 8) { float x[8]; unpack8(*(const u32x4*)(base + 8 * g), x);
#pragma unroll
            for (int e = 0; e < 8; ++e) x[e] *= sc;
            *(u32x4*)(base + 8 * g) = pack8(x); }
        else { const int gg = g - 8; float x1[8], x2[8], o1[8], o2[8]; unpack8(*(const u32x4*)(base + 64 + 8 * gg), x1); unpack8(*(const u32x4*)(base + 80 + 8 * gg), x2);
#pragma unroll
            for (int e = 0; e < 8; ++e) { const f32x2 cs = rm[(size_t)t * 16 + 8 * gg + e]; o1[e] = (x1[e] * cs.x - x2[e] * cs.y) * sc; o2[e] = (x2[e] * cs.x + x1[e] * cs.y) * sc; }
            *(u32x4*)(base + 64 + 8 * gg) = pack8(o1); *(u32x4*)(base + 80 + 8 * gg) = pack8(o2); } }
    for (int i = gt; i < TH * 64; i += NT) { const int t = i >> 6, h = (i >> 3) & 7, g = i & 7; float x[8]; unpack8(*(const u32x4*)(KVR + (size_t)t * 1024 + h * 128 + 8 * g), x); const float sc = rskv[t];
#pragma unroll
        for (int e = 0; e < 8; ++e) x[e] *= sc;
        *(u32x4*)(KN + (size_t)t * 512 + h * 64 + 8 * g) = pack8(x); }
    LAS bf16_t* img = (LAS bf16_t*)lds;
    for (int it = obid(); it < (TH / 64) * 8; it += gridDim.x) { const int tile = it >> 3, h = it & 7; const size_t t0 = (size_t)tile * 64; const int tok = tid >> 3, ch = 8 * (tid & 7);
        float x[8]; unpack8(*(const u32x4*)(KVR + (t0 + tok) * 1024 + h * 128 + 64 + ch), x); const float sc = rskv[t0 + tok];
#pragma unroll
        for (int e = 0; e < 8; ++e) img[(ch + e) * LS + tok] = f2bf(x[e] * sc);
        __syncthreads();
        *(u32x4*)(VT + (size_t)(h * 64 + tok) * TH + t0 + ch) = *(const LAS u32x4*)(img + tok * LS + ch);
        __syncthreads(); }
}

#ifndef DUP_ATTN
#define DUP_ATTN 1
#endif
#ifndef DUP_P1
#define DUP_P1 1
#endif
#ifndef DUP_P3
#define DUP_P3 1
#endif
#ifndef DUP_G
#define DUP_G 1
#endif
#define XB_TMO      128
#define XB_XCNT(j)  (256  + 64 * (j))
#define XB_XSUB(j)  (1280 + 64 * (j))
#define XB_XGEN(j)  (2304 + 64 * (j))
#define XB_TOP      3328
#define XB_TOPGEN   3392
#define XCD_BAR_WORDS 3456
#define XB_SPIN_CAP (1u << 18)

__device__ __forceinline__ unsigned xb_ld(unsigned* p)              { return __hip_atomic_load(p, __ATOMIC_RELAXED, __HIP_MEMORY_SCOPE_AGENT); }
__device__ __forceinline__ unsigned xb_add(unsigned* p, unsigned v) { return __hip_atomic_fetch_add(p, v, __ATOMIC_RELAXED, __HIP_MEMORY_SCOPE_AGENT); }
__device__ __forceinline__ unsigned xb_xcc_id() { return (unsigned)__builtin_amdgcn_s_getreg((3 << 11) | 20) & 0xFu; }
#define XB_SPIN(cond, bar) do { unsigned _sp = 0; while (cond) { __builtin_amdgcn_s_sleep(1); \
    if ((++_sp & 255u) == 0u) { if (xb_ld(&(bar)[XB_TMO])) break; if (_sp > XB_SPIN_CAP) { atomicAdd(&(bar)[XB_TMO], 1u); break; } } } } while (0)

struct XcdBarrier {
    unsigned* bar; unsigned x;
    volatile __attribute__((address_space(3))) unsigned* st;
};

__device__ __forceinline__ XcdBarrier xcd_barrier_post(unsigned* bar, volatile __attribute__((address_space(3))) unsigned* st) {
    XcdBarrier b; b.bar = bar; b.x = xb_xcc_id(); b.st = st;
    if (threadIdx.x == 0) (void)xb_add(&bar[XB_XCNT(b.x)], 1u);
    return b;
}
__device__ __forceinline__ void xcd_barrier_complete(unsigned* bar, unsigned x, unsigned& nloc, unsigned& nx) {
    const unsigned G = gridDim.x * gridDim.y * gridDim.z;
    unsigned sum, cnt, mine, sp = 0u;
    for (;;) {
        sum = 0u; cnt = 0u; mine = 0u;
#pragma unroll
        for (unsigned j = 0; j < 16; ++j) { const unsigned c = xb_ld(&bar[XB_XCNT(j)]); sum += c; cnt += (c > 0u) ? 1u : 0u; mine = (j == x) ? c : mine; }
        if (sum == G) break;
        __builtin_amdgcn_s_sleep(1);
        if ((++sp & 255u) == 0u) { if (xb_ld(&bar[XB_TMO])) break; if (sp > XB_SPIN_CAP) { atomicAdd(&bar[XB_TMO], 1u); break; } }
    }
    nloc = mine > 0u ? mine : 1u; nx = cnt > 0u ? cnt : 1u;
}

__device__ __forceinline__ void xcd_barrier(const XcdBarrier& b) {
    asm volatile("s_waitcnt vmcnt(0)" ::: "memory");
    __syncthreads();
    if (threadIdx.x == 0) {
        unsigned* bar = b.bar;
        __builtin_amdgcn_s_waitcnt(0);
        unsigned nloc = b.st[0], nx = b.st[1];
        if (nloc == 0u) { xcd_barrier_complete(bar, b.x, nloc, nx); b.st[0] = nloc; b.st[1] = nx; }
        const unsigned old = xb_add(&bar[XB_XSUB(b.x)], 1u);
        const unsigned gen = old / nloc;
        if (old + 1u == (gen + 1u) * nloc) {
            __builtin_amdgcn_fence(__ATOMIC_RELEASE, "agent");
            asm volatile("s_waitcnt vmcnt(0)" ::: "memory");
            const unsigned og = xb_add(&bar[XB_TOP], 1u);
            const unsigned tg = og / nx;
            if (og + 1u == (tg + 1u) * nx) xb_add(&bar[XB_TOPGEN], 1u);
            else XB_SPIN(xb_ld(&bar[XB_TOPGEN]) == tg, bar);
            __builtin_amdgcn_fence(__ATOMIC_ACQUIRE, "agent");
            xb_add(&bar[XB_XGEN(b.x)], 1u);
            asm volatile("s_waitcnt vmcnt(0)" ::: "memory");
        } else {
            XB_SPIN(xb_ld(&bar[XB_XGEN(b.x)]) == gen, bar);
            __builtin_amdgcn_fence(__ATOMIC_ACQUIRE, "agent");
            asm volatile("s_waitcnt vmcnt(0)" ::: "memory");
        }
    }
    __syncthreads();
}


constexpr int LDS_BYTES = pg8::STAGE_BYTES + 64;
constexpr size_t WS_BAR = WS_END, WS_BAR_BYTES = 16384, WS_TOTAL = WS_END + WS_BAR_BYTES;
template <class Epi, bool SP2 = true> DI void run_gemm(LAS unsigned char* lds, const bf16_t* A, int lda, const bf16_t* Bt, int ldb, int M, int N, int K, const Epi& E) {
    asm volatile("" : "+s"(K));
    pg8::Gemm g{A, Bt, M, N, K, lda, ldb}; pg8::StaticOrder S; S.init(M, N, (int)gridDim.x, obid());
    pg8::gemm_phase<Epi, pg8::StaticOrder, true, SP2>(lds, g, S, E);
}
#define wsb (ows(p.ws))
#define hn ((bf16_t*)(wsb + WS_HN))
#define proj ((bf16_t*)(wsb + WS_PROJ))
#define ys ((bf16_t*)(wsb + WS_YS))
__global__ void __launch_bounds__(512, 2) mega_fwd(KP p) {
    extern __shared__ __attribute__((aligned(16))) unsigned char lds_raw[];
    LAS unsigned char* lds = (LAS unsigned char*)lds_raw;
    cg::grid_group grid = cg::this_grid();
    { volatile LAS unsigned* st0 = (volatile LAS unsigned*)(lds + pg8::STAGE_BYTES); if (threadIdx.x < 16) st0[threadIdx.x] = 0u; __syncthreads(); }
    XcdBarrier xbar = xcd_barrier_post((unsigned*)(p.ws + WS_BAR), (volatile LAS unsigned*)(lds + pg8::STAGE_BYTES));
    bool first_seam = true;
#define GSYNC() do { if (first_seam) { grid.sync(); first_seam = false; } else xcd_barrier(xbar); } while (0)
    phase_rope_tables(p);
#pragma unroll 1
    for (int ly = 0; ly < NLAYER; ++ly) {
#pragma unroll 1
        for (int hf = 0; hf < 2; ++hf) {

#ifndef NO_WT
            if (hf == 0) { phase_weights(p, ly, lds); }
#endif

            phase_norm0(p, ly, hf);
            GSYNC();

#ifndef NO_G1
for (int dup_ = 0; dup_ < DUP_G; ++dup_) {
            { pg8::EpiStore<0> E{proj, NP, nullptr}; run_gemm(lds, hn, DM, (const bf16_t*)(wsb + WS_WIN), DM, TH, NP, DM, E); }
}

#endif

            GSYNC();

#ifndef NO_PREP
            phase_prep(p, ly, hf);
#endif

            GSYNC();

#ifndef NO_GQ
            { pg8::EpiStore<0> E{(bf16_t*)(wsb + WS_QM), 768, nullptr}; run_gemm(lds, proj + C_CQ, NP, (const bf16_t*)(wsb + WS_WUQ), 256, TH, 768, 256, E); }
#endif


#ifndef NO_GKV
            { pg8::EpiStore<0> E{(bf16_t*)(wsb + WS_KVR), 1024, nullptr}; run_gemm(lds, proj + C_CKV, NP, (const bf16_t*)(wsb + WS_WUKV), 128, TH, 1024, 128, E); }
#endif

            __syncthreads();

#ifndef NO_PASS1
for (int dup_ = 0; dup_ < DUP_P1; ++dup_) {
            for (int it = obid(); it < 4096; it += gridDim.x) { if (it < 2048) pass1_item<0>(p, it, lds); else if (it < 3072) pass1_item<1>(p, it - 2048, lds); else pass1_item<2>(p, it - 3072, lds); }
}

#endif

            GSYNC();

#ifndef NO_SCAN
            phase_scan(p);
            phase_mla_fix(p, hf, lds);
#endif

            GSYNC();

#ifndef NO_ATTN
for (int dup_ = 0; dup_ < DUP_ATTN; ++dup_) {
            for (int it = obid(); it < 256; it += gridDim.x) { const int b = it >> 7, h = (it >> 4) & 7, qa = it & 15;
                attn_unit(p, b, h, 31 - qa, lds); attn_unit(p, b, h, qa, lds); }
}

#endif


#ifndef NO_PASS3
for (int dup_ = 0; dup_ < DUP_P3; ++dup_) {
            for (int it = obid(); it < 4096; it += gridDim.x) { if (it < 2048) pass3_item<0>(p, ly, it, lds); else if (it < 3072) pass3_item<1>(p, ly, it - 2048, lds); else pass3_item<2>(p, ly, it - 3072, lds); }
}

#endif

            GSYNC();

#ifndef NO_GG
            { pg8::EpiStore<2> E{(bf16_t*)(wsb + WS_GATES), 4096, p.b_gate + (size_t)ly * 4096}; run_gemm(lds, hn, DM, (const bf16_t*)(wsb + WS_WG), DM, TH, 4096, DM, E); }
#endif

            GSYNC();

#ifndef NO_GM
            { bf16_t* mg = (bf16_t*)(wsb + WS_MERGED); const bf16_t* G = (const bf16_t*)(wsb + WS_GATES); const bf16_t* WB = (const bf16_t*)(wsb + WS_WB); const float* ssq = (const float*)(wsb + WS_SSQ);
              { pg8::EpiMerge E{mg, G, 0, ssq, 0, 1}; run_gemm(lds, ys, 2048, WB, 512, TH, DM, 256, E); }
              { pg8::EpiMerge E{mg, G, 0, ssq, 8, 0}; run_gemm(lds, ys + 256, 2048, WB + 256, 512, TH, DM, 256, E); }
#pragma unroll 1
              for (int br = 1; br < 4; ++br) { pg8::EpiMerge E{mg, G, br * 1024, nullptr, 0, 0}; run_gemm(lds, ys + br * 512, 2048, WB + (size_t)br * DM * 512, 512, TH, DM, 512, E); } }
#endif

            GSYNC();

#ifndef NO_GO
            { pg8::EpiStore<0> E{(bf16_t*)(wsb + WS_T), DM, nullptr}; run_gemm(lds, (const bf16_t*)(wsb + WS_MERGED), DM, (const bf16_t*)(wsb + WS_WO), DM, TH, DM, DM, E); }
#endif

            GSYNC();
            phase_norm_res(p, hf, ly == 0 ? p.x : p.out, p.n_post_mix + ly * DM, p.n_pre_mlp + ly * DM);
            GSYNC();

#ifndef NO_G2
for (int dup_ = 0; dup_ < DUP_G; ++dup_) {
            { pg8::EpiStore<1> E{(bf16_t*)(wsb + WS_U), DFF, nullptr}; run_gemm(lds, hn, DM, (const bf16_t*)(wsb + WS_W1), DM, TH, DFF, DM, E); }
}

#endif

            GSYNC();

#ifndef NO_G3
            { pg8::EpiStore<0> E{(bf16_t*)(wsb + WS_T), DM, nullptr}; run_gemm(lds, (const bf16_t*)(wsb + WS_U), DFF, (const bf16_t*)(wsb + WS_W2), DFF, TH, DM, DFF, E); }
#endif

            GSYNC();
            phase_norm_res(p, hf, p.out, p.n_post_mlp + ly * DM, nullptr);
            __syncthreads();
        }
    }
}

#undef wsb
#undef hn
#undef proj
#undef ys
extern "C" void kernel_launch(void* const* d_in, const int* in_sizes, int n_in, void* d_out, int out_size, void* d_ws, size_t ws_size, hipStream_t stream) {
    static int grid_blocks = 0;
    if (grid_blocks == 0) {
        if (n_in != 26 || ws_size < WS_TOTAL) { fprintf(stderr, "kernel_launch: unexpected n_in %d or ws_size %zu (< %zu)\n", n_in, ws_size, (size_t)WS_END); grid_blocks = -1; return; }
        int dev = 0, cus = 0, per_cu = 0;
        hipGetDevice(&dev); hipDeviceGetAttribute(&cus, hipDeviceAttributeMultiprocessorCount, dev);
        if (hipFuncSetAttribute((const void*)mega_fwd, hipFuncAttributeMaxDynamicSharedMemorySize, LDS_BYTES) != hipSuccess) { fprintf(stderr, "kernel_launch: hipFuncSetAttribute failed\n"); grid_blocks = -1; return; }
        if (hipOccupancyMaxActiveBlocksPerMultiprocessor(&per_cu, (const void*)mega_fwd, 512, LDS_BYTES) != hipSuccess || per_cu < 1) { fprintf(stderr, "kernel_launch: occupancy query gave %d\n", per_cu); per_cu = 1; }
        (void)hipGetLastError();
        grid_blocks = cus * 1;
    }
    if (grid_blocks < 0) return;
    KP p{};
    const float** pf = (const float**)&p;
    p.x = (const float*)d_in[0]; p.pos = (const int*)d_in[1];
    p.w_in = (const float*)d_in[2]; p.b_gate = (const float*)d_in[3]; p.conv_w = (const float*)d_in[4]; p.conv_b = (const float*)d_in[5]; p.dt_bias = (const float*)d_in[6];
    p.a_log = (const float*)d_in[7]; p.ssd_d = (const float*)d_in[8]; p.ssd_norm = (const float*)d_in[9]; p.ret_norm = (const float*)d_in[10]; p.mla_q_norm = (const float*)d_in[11];
    p.w_uq = (const float*)d_in[12]; p.mla_kv_norm = (const float*)d_in[13]; p.w_ukv = (const float*)d_in[14]; p.w_gk2 = (const float*)d_in[15]; p.b_gk = (const float*)d_in[16];
    p.gla_norm = (const float*)d_in[17]; p.w_branch = (const float*)d_in[18]; p.w_out = (const float*)d_in[19]; p.n_pre_mix = (const float*)d_in[20]; p.n_post_mix = (const float*)d_in[21];
    p.n_pre_mlp = (const float*)d_in[22]; p.n_post_mlp = (const float*)d_in[23]; p.w_mlp_in = (const float*)d_in[24]; p.w_mlp_out = (const float*)d_in[25];
    p.out = (float*)d_out; p.ws = (unsigned char*)d_ws; (void)pf;
    if (hipMemsetAsync((char*)d_ws + WS_BAR, 0, WS_BAR_BYTES, stream) != hipSuccess) { fprintf(stderr, "kernel_launch: memset of barrier words failed\n"); return; }
    void* args[] = {&p};
    hipError_t e = hipLaunchCooperativeKernel((const void*)mega_fwd, dim3(grid_blocks), dim3(512), args, LDS_BYTES, stream);
    if (e != hipSuccess) fprintf(stderr, "kernel_launch: cooperative launch failed: %s (grid %d)\n", hipGetErrorString(e), grid_blocks);
}
```
